# Optimizing an MI355X kernel written in HIP

```python
import jax, jax.numpy as jnp
from jax import lax
import numpy as np

D_MODEL = 1024
BATCH = 8
SEQ = 4096
DEPTH = 1

D_FF = 2816
D_A = D_MODEL
D_B = D_MODEL
GROUP = 128
CONV_A = 31
CONV_B = 3
EPS = 1e-6
SPLITS = (D_A, 2 * D_A, 2 * D_A + D_B, 2 * D_A + 2 * D_B, 2 * D_A + 3 * D_B, 2 * D_A + 3 * D_B + D_MODEL)
D_IN = 2 * D_A + 3 * D_B + 2 * D_MODEL

kernel_name = "macaron_gated_conformer_shortconv_hybrid"


def rmsnorm(x, g):
    xf = x.astype(jnp.float32)
    y = xf * lax.rsqrt(jnp.mean(xf * xf, axis=-1, keepdims=True) + EPS)
    return (y * g.astype(jnp.float32)).astype(x.dtype)


def layernorm(x, g, b):
    xf = x.astype(jnp.float32)
    mu = jnp.mean(xf, axis=-1, keepdims=True)
    var = jnp.mean(jnp.square(xf - mu), axis=-1, keepdims=True)
    y = (xf - mu) * lax.rsqrt(var + EPS)
    return (y * g.astype(jnp.float32) + b.astype(jnp.float32)).astype(x.dtype)


def swiglu(x, w_gate, w_up, w_down):
    return (jax.nn.silu(x @ w_gate) * (x @ w_up)) @ w_down


def causal_depthwise_conv(x, w):
    k, c = w.shape
    return lax.conv_general_dilated(
        x, w[:, None, :].astype(x.dtype), window_strides=(1,), padding=((k - 1, 0),),
        dimension_numbers=("NWC", "WIO", "NWC"), feature_group_count=c)


def setup_inputs(seed: int = 0) -> dict:
    key = jax.random.key(seed)
    ks = jax.random.split(key, 24)
    f32 = jnp.float32

    def nrm(k, shape, fan_in):
        return jax.random.normal(k, shape, f32) * (fan_in ** -0.5)

    def gain(k, shape):
        return 1.0 + 0.01 * jax.random.normal(k, shape, f32)

    L = DEPTH
    return {
        "x": jax.random.normal(ks[0], (BATCH, SEQ, D_MODEL), f32),
        "ffn1_norm": gain(ks[1], (L, D_MODEL)),
        "ffn1_w_gate": nrm(ks[2], (L, D_MODEL, D_FF), D_MODEL),
        "ffn1_w_up": nrm(ks[3], (L, D_MODEL, D_FF), D_MODEL),
        "ffn1_w_down": nrm(ks[4], (L, D_FF, D_MODEL), D_FF),
        "mix_norm": gain(ks[5], (L, D_MODEL)),
        "w_in": nrm(ks[6], (L, D_MODEL, D_IN), D_MODEL),
        "a_dw_w": nrm(ks[7], (L, CONV_A, D_A), CONV_A),
        "a_dw_b": 0.01 * jax.random.normal(ks[8], (L, D_A), f32),
        "a_ln_g": gain(ks[9], (L, D_A)),
        "a_ln_b": 0.01 * jax.random.normal(ks[10], (L, D_A), f32),
        "a_w_out": nrm(ks[11], (L, D_A, D_MODEL), D_A),
        "b_conv_w": nrm(ks[12], (L, CONV_B, D_B), CONV_B),
        "b_w_out": nrm(ks[13], (L, D_B, D_MODEL), D_B),
        "w_o": nrm(ks[14], (L, D_MODEL, D_MODEL), D_MODEL),
        "ffn2_norm": gain(ks[15], (L, D_MODEL)),
        "ffn2_w_gate": nrm(ks[16], (L, D_MODEL, D_FF), D_MODEL),
        "ffn2_w_up": nrm(ks[17], (L, D_MODEL, D_FF), D_MODEL),
        "ffn2_w_down": nrm(ks[18], (L, D_FF, D_MODEL), D_FF),
        "final_norm": gain(ks[19], (D_MODEL,)),
    }


def reference(x, ffn1_norm, ffn1_w_gate, ffn1_w_up, ffn1_w_down, mix_norm, w_in,
              a_dw_w, a_dw_b, a_ln_g, a_ln_b, a_w_out, b_conv_w, b_w_out, w_o,
              ffn2_norm, ffn2_w_gate, ffn2_w_up, ffn2_w_down, final_norm):
    h = x
    for l in range(DEPTH):
        h = h + 0.5 * swiglu(rmsnorm(h, ffn1_norm[l]), ffn1_w_gate[l], ffn1_w_up[l], ffn1_w_down[l])

        u = rmsnorm(h, mix_norm[l])
        z = u @ w_in[l]
        a_val, a_gate, b_B, b_C, b_x, g_a, g_b = jnp.split(z, SPLITS, axis=-1)

        a = a_val * jax.nn.sigmoid(a_gate)
        a = causal_depthwise_conv(a, a_dw_w[l]) + a_dw_b[l]
        a = jax.nn.silu(layernorm(a, a_ln_g[l], a_ln_b[l]))
        y_a = a @ a_w_out[l]

        v = causal_depthwise_conv(b_C * b_x, b_conv_w[l])
        y_b = (b_B * v) @ b_w_out[l]

        m = jax.nn.sigmoid(g_a) * y_a + jax.nn.sigmoid(g_b) * y_b
        h = h + m @ w_o[l]

        h = h + 0.5 * swiglu(rmsnorm(h, ffn2_norm[l]), ffn2_w_gate[l], ffn2_w_up[l], ffn2_w_down[l])
    return rmsnorm(h, final_norm)
```

```cpp
#include <hip/hip_runtime.h>
#include <cstdio>
#include <cstdint>

#ifndef MK_N_LAUNCHES
#define MK_N_LAUNCHES 10
#endif

namespace pg8 {
#define PG8_LAS __attribute__((address_space(3)))
typedef unsigned short bf16_t;
typedef short bf16x8 __attribute__((ext_vector_type(8)));
typedef float f32x4 __attribute__((ext_vector_type(4)));
typedef unsigned u32x4 __attribute__((ext_vector_type(4)));
constexpr int BM = 256, BK = 64, HALF = 128, HTB = HALF * BK * 2  , STAGE_BYTES = 8 * HTB, NXCD = 8, WGM = 8;

__host__ __device__ __forceinline__ int lds_byte(int r, int c) { const int st = (r >> 4) * 2 + (c >> 5), rr = r & 15, cc = c & 31, ob = rr * 64 + cc * 2; return st * 1024 + (ob ^ (((ob >> 9) & 1) << 5)); }
__host__ __device__ __forceinline__ void stage_rc(int b, int& R, int& C) { const int st = b / 1024, sb = b % 1024, swz = sb ^ (((sb >> 9) & 1) << 5); R = (st >> 1) * 16 + swz / 64; C = (st & 1) * 32 + (swz % 64) / 2; }
__host__ __device__ __forceinline__ int perm32(int rho) { const int n = rho >> 4, i = rho & 15; return 8 * (i >> 2) + 4 * n + (i & 3); }

struct Unit { int pm, pn, sel; };
struct Gemm { const bf16_t* A; const bf16_t* Bt; const bf16_t* A2; const bf16_t* Bt2; int M, N, K; };

struct StaticOrder {
    int nM, nN, nwg, G, c;
    __device__ void init(int M, int N, int G_, int c_) { nM = M / BM; nN = N / BM; nwg = nM * nN; G = G_; c = c_; }
    __device__ bool next(int i, Unit& u) const {
        const long L = (long)i * G + c; if (L >= nwg) return false;
        int wgid = (int)L; { const int q = nwg / NXCD, r = nwg % NXCD, xcd = wgid % NXCD, off = wgid / NXCD; wgid = (xcd < r ? xcd * (q + 1) : r * (q + 1) + (xcd - r) * q) + off; }
        const int nig = WGM * nN, gid = wgid / nig, fm = gid * WGM, gsz = (nM - fm) < WGM ? (nM - fm) : WGM;
        u.pm = fm + ((wgid % nig) % gsz); u.pn = (wgid % nig) / gsz; u.sel = 0; return true;
    }
};
struct DualOrder {
    StaticOrder s;
    __device__ bool next(int j, Unit& u) const { if (!s.next(j >> 1, u)) return false; u.sel = j & 1; return true; }
};

__device__ __forceinline__ unsigned cvt_pk_bf16(float lo, float hi) { unsigned r; asm volatile("v_cvt_pk_bf16_f32 %0, %1, %2" : "=v"(r) : "v"(lo), "v"(hi)); return r; }

template <class Epi, class Sched, bool ALIGN_EPI = false, bool SP2 = false>
__device__ __forceinline__ void gemm_phase(PG8_LAS unsigned char* lds, const Gemm g, const Sched& S, const Epi& E) {
    const int tid = threadIdx.x, wid = __builtin_amdgcn_readfirstlane(tid >> 6), lane = tid & 63, wr = wid >> 2, wc = wid & 3, fr = lane & 15, fq = lane >> 4;
    const int K = g.K, nt = K / BK;
    unsigned voffA[2], voffB[2];
#pragma unroll
    for (int i = 0; i < 2; ++i) { int R, C; stage_rc(tid * 16 + i * 8192, R, C); const int Rb = Epi::PERM ? ((R & ~31) + perm32(R & 31)) : R;
        voffA[i] = (unsigned)(R * K + C) * 2u; voffB[i] = (unsigned)(Rb * K + C) * 2u; }
    const size_t kstep = (size_t)(BK * 2);
    const size_t hstep = (size_t)HALF * K * 2;
    const size_t tstep = 2 * hstep;
    const unsigned ldsw = (unsigned)wid * 1024u;
    const int aoff = lds_byte(wr * 64 + fr, fq * 8), boff = lds_byte(wc * 32 + fr, fq * 8);
#define PG8_SA(b, h) (((b) * 2 + (h)) * HTB)
#define PG8_SB(b, h) ((4 + (b) * 2 + (h)) * HTB)
#define PG8_STAGE(bufoff, gbase, voff) do { _Pragma("unroll") for (int _i = 0; _i < 2; ++_i) \
        __builtin_amdgcn_global_load_lds((const unsigned*)((const char*)(gbase) + (voff)[_i]), (PG8_LAS unsigned*)(lds + (bufoff) + ldsw + _i * 8192), 16, 0, 0); } while (0)
#define PG8_LDA(dst, b, h) do { _Pragma("unroll") for (int m = 0; m < 4; ++m) _Pragma("unroll") for (int k = 0; k < 2; ++k) dst[m][k] = *(const PG8_LAS bf16x8*)(lds + PG8_SA(b, h) + aoff + m * 2048 + k * 1024); } while (0)
#define PG8_LDB(dst, b, h) do { _Pragma("unroll") for (int n = 0; n < 2; ++n) _Pragma("unroll") for (int k = 0; k < 2; ++k) dst[n][k] = *(const PG8_LAS bf16x8*)(lds + PG8_SB(b, h) + boff + n * 2048 + k * 1024); } while (0)
#define PG8_MMA(ai, bj, At, Bt) do { __builtin_amdgcn_s_setprio(1); _Pragma("unroll") for (int m = 0; m < 4; ++m) _Pragma("unroll") for (int n = 0; n < 2; ++n) _Pragma("unroll") for (int k = 0; k < 2; ++k) \
        acc[ai][bj][m][n] = __builtin_amdgcn_mfma_f32_16x16x32_bf16(Bt[n][k], At[m][k], acc[ai][bj][m][n], 0, 0, 0); __builtin_amdgcn_s_setprio(0); } while (0)
#define PG8_WAIT_V(n) asm volatile("s_waitcnt vmcnt(" #n ")" ::: "memory")
#define PG8_WAIT_L(n) asm volatile("s_waitcnt lgkmcnt(" #n ")" ::: "memory")
#define PG8_BAR __builtin_amdgcn_s_barrier()
#define PG8_SCHED __builtin_amdgcn_sched_barrier(0)
#define PG8_ABASE(u) ((const char*)((u).sel ? g.A2 : g.A) + (size_t)(u).pm * tstep)
#define PG8_BBASE(u) ((const char*)((u).sel ? g.Bt2 : g.Bt) + (size_t)(u).pn * tstep)
    Unit cur, nxt; int ui = 0;
    if (!S.next(0, cur)) return;
    f32x4 acc[2][2][4][2];
#pragma unroll
    for (int a = 0; a < 2; ++a)
#pragma unroll
        for (int b = 0; b < 2; ++b)
#pragma unroll
            for (int m = 0; m < 4; ++m)
#pragma unroll
                for (int n = 0; n < 2; ++n) acc[a][b][m][n] = (f32x4){0.f, 0.f, 0.f, 0.f};
    bf16x8 At[4][2], B0[2][2], B1[2][2];
    const char* cA = PG8_ABASE(cur); const char* cB = PG8_BBASE(cur);
    if constexpr (SP2) {
        PG8_STAGE(PG8_SB(0, 0), cB, voffB); PG8_STAGE(PG8_SB(0, 1), cB + hstep, voffB); PG8_STAGE(PG8_SA(0, 0), cA, voffA); PG8_STAGE(PG8_SA(0, 1), cA + hstep, voffA);
        if (wr == 1) PG8_BAR;
        PG8_WAIT_V(2); PG8_BAR;
        PG8_STAGE(PG8_SB(1, 0), cB + kstep, voffB); PG8_STAGE(PG8_SA(1, 0), cA + kstep, voffA); PG8_STAGE(PG8_SB(1, 1), cB + hstep + kstep, voffB);
        PG8_WAIT_V(6); PG8_BAR;
    } else {
        PG8_STAGE(PG8_SB(0, 0), cB, voffB); PG8_STAGE(PG8_SA(0, 0), cA, voffA); PG8_STAGE(PG8_SB(0, 1), cB + hstep, voffB); PG8_STAGE(PG8_SA(0, 1), cA + hstep, voffA);
        if (wr == 1) PG8_BAR;
        PG8_WAIT_V(4); PG8_BAR;
        PG8_STAGE(PG8_SB(1, 0), cB + kstep, voffB); PG8_STAGE(PG8_SA(1, 0), cA + kstep, voffA); PG8_STAGE(PG8_SB(1, 1), cB + hstep + kstep, voffB);
        PG8_WAIT_V(6); PG8_BAR;
    }
    for (;;) {
        const bool has_next = S.next(ui + 1, nxt);
        const char* nA = has_next ? PG8_ABASE(nxt) : cA; const char* nB = has_next ? PG8_BBASE(nxt) : cB;
        for (int t = 0; t < nt; t += 2) {
            const bool last = (t == nt - 2);
            const char* a1 = cA + (size_t)(t + 1) * kstep;
            const char* a2 = last ? nA : cA + (size_t)(t + 2) * kstep; const char* b2 = last ? nB : cB + (size_t)(t + 2) * kstep;
            const char* a3 = a2 + kstep; const char* b3 = b2 + kstep;
            if constexpr (SP2) {
            PG8_LDB(B0, 0, 0); PG8_LDB(B1, 0, 1); PG8_SCHED; PG8_LDA(At, 0, 0); PG8_STAGE(PG8_SA(1, 1), a1 + hstep, voffA);
            PG8_WAIT_V(8); PG8_WAIT_L(0); PG8_BAR; PG8_MMA(0, 0, At, B0); PG8_MMA(0, 1, At, B1); PG8_BAR; PG8_SCHED;
            PG8_LDA(At, 0, 1); PG8_STAGE(PG8_SB(0, 0), b2, voffB); PG8_STAGE(PG8_SB(0, 1), b2 + hstep, voffB); PG8_STAGE(PG8_SA(0, 0), a2, voffA);
            PG8_WAIT_V(8); PG8_WAIT_L(0); PG8_BAR; PG8_MMA(1, 0, At, B0); PG8_MMA(1, 1, At, B1); PG8_BAR; PG8_SCHED;
            PG8_LDB(B0, 1, 0); PG8_LDB(B1, 1, 1); PG8_SCHED; PG8_LDA(At, 1, 0); PG8_STAGE(PG8_SA(0, 1), a2 + hstep, voffA);
            PG8_WAIT_V(8); PG8_WAIT_L(0); PG8_BAR; PG8_MMA(0, 0, At, B0); PG8_MMA(0, 1, At, B1); PG8_BAR; PG8_SCHED;
            PG8_LDA(At, 1, 1); PG8_STAGE(PG8_SB(1, 0), b3, voffB); PG8_STAGE(PG8_SB(1, 1), b3 + hstep, voffB); PG8_STAGE(PG8_SA(1, 0), a3, voffA);
            PG8_WAIT_V(8); PG8_WAIT_L(0); PG8_BAR; PG8_MMA(1, 0, At, B0); PG8_MMA(1, 1, At, B1); PG8_BAR; PG8_SCHED;
            } else {
            PG8_LDB(B0, 0, 0); PG8_SCHED; PG8_LDA(At, 0, 0); PG8_STAGE(PG8_SA(1, 1), a1 + hstep, voffA);
            PG8_WAIT_L(8); PG8_BAR; PG8_WAIT_L(0); PG8_MMA(0, 0, At, B0); PG8_BAR; PG8_SCHED;
            PG8_LDB(B1, 0, 1); PG8_STAGE(PG8_SB(0, 0), b2, voffB);
            PG8_BAR; PG8_WAIT_L(0); PG8_MMA(0, 1, At, B1); PG8_BAR;
            PG8_LDA(At, 0, 1); PG8_STAGE(PG8_SA(0, 0), a2, voffA);
            PG8_BAR; PG8_WAIT_L(0); PG8_MMA(1, 0, At, B0); PG8_BAR; PG8_SCHED;
            PG8_STAGE(PG8_SB(0, 1), b2 + hstep, voffB);
            PG8_WAIT_V(6); PG8_BAR; PG8_MMA(1, 1, At, B1); PG8_BAR;
            PG8_LDB(B0, 1, 0); PG8_SCHED; PG8_LDA(At, 1, 0); PG8_STAGE(PG8_SA(0, 1), a2 + hstep, voffA);
            PG8_WAIT_L(8); PG8_BAR; PG8_WAIT_L(0); PG8_MMA(0, 0, At, B0); PG8_BAR; PG8_SCHED;
            PG8_LDB(B1, 1, 1); PG8_STAGE(PG8_SB(1, 0), b3, voffB);
            PG8_BAR; PG8_WAIT_L(0); PG8_MMA(0, 1, At, B1); PG8_BAR;
            PG8_LDA(At, 1, 1); PG8_STAGE(PG8_SA(1, 0), a3, voffA);
            PG8_BAR; PG8_WAIT_L(0); PG8_MMA(1, 0, At, B0); PG8_BAR; PG8_SCHED;
            PG8_STAGE(PG8_SB(1, 1), b3 + hstep, voffB);
            PG8_WAIT_V(6); PG8_BAR; PG8_MMA(1, 1, At, B1); PG8_BAR;
            }
        }
        if constexpr (ALIGN_EPI) { if (wr == 0) PG8_BAR; }
        bool keep = false;
        if constexpr (Epi::DUAL) { if (cur.sel == 0) { E.mid(acc, cur, wr, wc, fr, fq); keep = true; } else E(acc, cur, wr, wc, fr, fq); }
        else E(acc, cur, wr, wc, fr, fq);
        if (!has_next) break;
        if (!keep) {
#pragma unroll
        for (int a = 0; a < 2; ++a)
#pragma unroll
            for (int b = 0; b < 2; ++b)
#pragma unroll
                for (int m = 0; m < 4; ++m)
#pragma unroll
                    for (int n = 0; n < 2; ++n) acc[a][b][m][n] = (f32x4){0.f, 0.f, 0.f, 0.f};
        }
        cur = nxt; cA = nA; cB = nB; ++ui;
        if constexpr (ALIGN_EPI) { if (wr == 1) PG8_BAR; }
    }
    PG8_WAIT_V(0);
    if constexpr (!ALIGN_EPI) { if (wr == 0) PG8_BAR; }
    PG8_BAR;
#undef PG8_SA
#undef PG8_SB
#undef PG8_STAGE
#undef PG8_LDA
#undef PG8_LDB
#undef PG8_MMA
#undef PG8_WAIT_V
#undef PG8_WAIT_L
#undef PG8_BAR
#undef PG8_SCHED
#undef PG8_ABASE
#undef PG8_BBASE
}
}

#ifndef PG8_SP2
#define PG8_SP2 true
#endif
#ifndef PG8_ALIGN
#define PG8_ALIGN true
#endif

constexpr int NWAVES = 8;
constexpr int BATCH = 8, SEQ = 4096, D = 1024, FF = 2816, DIN = 7168, CA = 31, CB = 3;
constexpr int M = BATCH * SEQ;
constexpr float EPS = 1e-6f;
constexpr int N_PHASES = 10;

constexpr size_t MiB = 1u << 20;
constexpr size_t WS_CTL = 0, CTL_ZERO_BYTES = 64 * 1024;
constexpr size_t WS_SSP1 = 1 * MiB, WS_SSP2 = 3 * MiB, WS_SSP3 = 5 * MiB;
constexpr size_t WS_W1 = 8 * MiB, WS_WD1 = 19 * MiB, WS_WIN = 25 * MiB, WS_WA = 39 * MiB, WS_WB = 41 * MiB, WS_WO = 43 * MiB, WS_W2 = 45 * MiB, WS_WD2 = 56 * MiB;
constexpr size_t WS_RA = 64 * MiB;
constexpr size_t WS_Z = 128 * MiB;
constexpr size_t WS_HID = 128 * MiB;
constexpr size_t WS_END = 448 * MiB;
constexpr size_t ZS = (size_t)M * D;
static_assert(WS_W1 + (size_t)2 * FF * D * 2 <= WS_WD1 && WS_WD1 + (size_t)D * FF * 2 <= WS_WIN && WS_WIN + (size_t)DIN * D * 2 <= WS_WA && WS_W2 + (size_t)2 * FF * D * 2 <= WS_WD2 && WS_WD2 + (size_t)D * FF * 2 <= WS_RA, "weights map");
static_assert(WS_HID + (size_t)M * FF * 2 <= WS_Z + 3 * ZS * 2 && WS_Z + 5 * ZS * 2 <= WS_END, "activation map");
constexpr int CW_BAR = 1024;

constexpr int RING_BYTES = 131072;
constexpr int LDSCTL_OFF = RING_BYTES, MISC_OFF = LDSCTL_OFF + 320;
constexpr int LDS_BYTES = 147456;

#define GAS __attribute__((address_space(1)))
#define LAS __attribute__((address_space(3)))
typedef unsigned short bf16;
typedef unsigned v4u __attribute__((ext_vector_type(4)));
typedef unsigned v2u __attribute__((ext_vector_type(2)));
typedef float f32x4 __attribute__((ext_vector_type(4)));
typedef float f32x2 __attribute__((ext_vector_type(2)));
typedef GAS unsigned gu32;
#define RLX_AGENT __ATOMIC_RELAXED, __HIP_MEMORY_SCOPE_AGENT
#define LDS_WAIT() asm volatile("s_waitcnt lgkmcnt(0)" ::: "memory")
#define VM_WAIT() asm volatile("s_waitcnt vmcnt(0)" ::: "memory")
__device__ __forceinline__ unsigned f2bf(float f) { unsigned u = __builtin_bit_cast(unsigned, f); return (u + 0x7fffu + ((u >> 16) & 1u)) >> 16; }
__device__ __forceinline__ unsigned pk2(float lo, float hi) { return f2bf(lo) | (f2bf(hi) << 16); }
__device__ __forceinline__ float bflo(unsigned x) { return __builtin_bit_cast(float, x << 16); }
__device__ __forceinline__ float bfhi(unsigned x) { return __builtin_bit_cast(float, x & 0xffff0000u); }
__device__ __forceinline__ float fast_exp(float x) { return __builtin_amdgcn_exp2f(x * 1.44269504089f); }
__device__ __forceinline__ float fast_rcp(float x) { return __builtin_amdgcn_rcpf(x); }
__device__ __forceinline__ float sigmoidf_(float x) { return fast_rcp(1.0f + fast_exp(-x)); }

#define XB_TMO      128
#define XB_XCNT(j)  (256  + 64 * (j))
#define XB_XSUB(j)  (1280 + 64 * (j))
#define XB_XGEN(j)  (2304 + 64 * (j))
#define XB_TOP      3328
#define XB_TOPGEN   3392
#define XCD_BAR_WORDS 3456
#define XB_SPIN_CAP (1u << 18)
static_assert((CW_BAR + XCD_BAR_WORDS) * 4 <= (int)CTL_ZERO_BYTES, "barrier words inside the memset region");
__device__ __forceinline__ unsigned xb_ld(unsigned* p)              { return __hip_atomic_load(p, __ATOMIC_RELAXED, __HIP_MEMORY_SCOPE_AGENT); }
__device__ __forceinline__ unsigned xb_add(unsigned* p, unsigned v) { return __hip_atomic_fetch_add(p, v, __ATOMIC_RELAXED, __HIP_MEMORY_SCOPE_AGENT); }
__device__ __forceinline__ unsigned xb_xcc_id() { return (unsigned)__builtin_amdgcn_s_getreg((3 << 11) | 20) & 0xFu; }
#define XB_SPIN(cond, bar) do { unsigned _sp = 0; while (cond) { __builtin_amdgcn_s_sleep(1); \
    if ((++_sp & 255u) == 0u) { if (xb_ld(&(bar)[XB_TMO])) break; if (_sp > XB_SPIN_CAP) { atomicAdd(&(bar)[XB_TMO], 1u); break; } } } } while (0)
struct XcdBarrier { unsigned* bar; unsigned x; volatile LAS unsigned* st; };
__device__ __forceinline__ XcdBarrier xcd_barrier_post(unsigned* bar, volatile LAS unsigned* st) {
    XcdBarrier b; b.bar = bar; b.x = xb_xcc_id(); b.st = st;
    if (threadIdx.x == 0) (void)xb_add(&bar[XB_XCNT(b.x)], 1u);
    return b;
}
__device__ __forceinline__ void xcd_barrier_complete(unsigned* bar, unsigned x, unsigned& nloc, unsigned& nx) {
    const unsigned G = gridDim.x * gridDim.y * gridDim.z;
    unsigned sum, cnt, mine, sp = 0u;
    for (;;) {
        sum = 0u; cnt = 0u; mine = 0u;
#pragma unroll
        for (unsigned j = 0; j < 16; ++j) { const unsigned c = xb_ld(&bar[XB_XCNT(j)]); sum += c; cnt += (c > 0u) ? 1u : 0u; mine = (j == x) ? c : mine; }
        if (sum == G) break;
        __builtin_amdgcn_s_sleep(1);
        if ((++sp & 255u) == 0u) { if (xb_ld(&bar[XB_TMO])) break; if (sp > XB_SPIN_CAP) { atomicAdd(&bar[XB_TMO], 1u); break; } }
    }
    nloc = mine > 0u ? mine : 1u; nx = cnt > 0u ? cnt : 1u;
}
__device__ __forceinline__ void xcd_barrier(const XcdBarrier& b) {
    asm volatile("s_waitcnt vmcnt(0)" ::: "memory");
    __syncthreads();
    if (threadIdx.x == 0) {
        unsigned* bar = b.bar;
        __builtin_amdgcn_s_waitcnt(0);
        unsigned nloc = b.st[0], nx = b.st[1];
        if (nloc == 0u) { xcd_barrier_complete(bar, b.x, nloc, nx); b.st[0] = nloc; b.st[1] = nx; }
        const unsigned old = xb_add(&bar[XB_XSUB(b.x)], 1u);
        const unsigned gen = old / nloc;
        if (old + 1u == (gen + 1u) * nloc) {
            __builtin_amdgcn_fence(__ATOMIC_RELEASE, "agent");
            asm volatile("s_waitcnt vmcnt(0)" ::: "memory");
            const unsigned og = xb_add(&bar[XB_TOP], 1u);
            const unsigned tg = og / nx;
            if (og + 1u == (tg + 1u) * nx) xb_add(&bar[XB_TOPGEN], 1u);
            else XB_SPIN(xb_ld(&bar[XB_TOPGEN]) == tg, bar);
            __builtin_amdgcn_fence(__ATOMIC_ACQUIRE, "agent");
            xb_add(&bar[XB_XGEN(b.x)], 1u);
            asm volatile("s_waitcnt vmcnt(0)" ::: "memory");
        } else {
            XB_SPIN(xb_ld(&bar[XB_XGEN(b.x)]) == gen, bar);
            __builtin_amdgcn_fence(__ATOMIC_ACQUIRE, "agent");
            asm volatile("s_waitcnt vmcnt(0)" ::: "memory");
        }
    }
    __syncthreads();
}

__device__ __forceinline__ float row_rstd(const float* ssp, int row, int fq) {
    const f32x4 v = *(const f32x4*)(ssp + (size_t)row * 16 + 4 * fq);
    float s = (v.x + v.y) + (v.z + v.w);
    s += __shfl_xor(s, 16); s += __shfl_xor(s, 32);
    return rsqrtf(s * (1.0f / D) + EPS);
}
__device__ __forceinline__ v4u pack8(const f32x4& a, const f32x4& b) {
    v4u w; w.x = pg8::cvt_pk_bf16(a[0], a[1]); w.y = pg8::cvt_pk_bf16(a[2], a[3]); w.z = pg8::cvt_pk_bf16(b[0], b[1]); w.w = pg8::cvt_pk_bf16(b[2], b[3]); return w;
}
__device__ __forceinline__ void unpack8(const v4u& w, f32x4& a, f32x4& b) {
    a = (f32x4){bflo(w.x), bfhi(w.x), bflo(w.y), bfhi(w.y)}; b = (f32x4){bflo(w.z), bfhi(w.z), bflo(w.w), bfhi(w.w)};
}
__device__ __forceinline__ f32x4 silu_mul4(const f32x4& g, const f32x4& u) {
    f32x4 o;
#pragma unroll
    for (int j = 0; j < 4; ++j) o[j] = g[j] * u[j] * sigmoidf_(g[j]);
    return o;
}
struct EpiSwiglu {
    static constexpr bool PERM = true, DUAL = false;
    bf16* H; const float* ssp;
    __device__ __forceinline__ void operator()(pg8::f32x4 (&acc)[2][2][4][2], const pg8::Unit& u, int wr, int wc, int fr, int fq) const {
        const int row0 = u.pm * 256 + wr * 64 + fr, col0 = u.pn * 128 + wc * 32 + 8 * fq;
#pragma unroll
        for (int ai = 0; ai < 2; ++ai)
#pragma unroll
            for (int m = 0; m < 4; ++m) {
                const int row = row0 + ai * 128 + m * 16; const float rs = row_rstd(ssp, row, fq);
                const f32x4 h0 = silu_mul4(acc[ai][0][m][0] * rs, acc[ai][1][m][0] * rs), h1 = silu_mul4(acc[ai][0][m][1] * rs, acc[ai][1][m][1] * rs);
                *(v4u*)(H + (size_t)row * FF + col0) = pack8(h0, h1);
            }
    }
};
template <bool WB, bool SS> struct EpiResid {
    static constexpr bool PERM = true, DUAL = false;
    const float* base; float* out; bf16* hb; float* ssp; float alpha;
    __device__ __forceinline__ void operator()(pg8::f32x4 (&acc)[2][2][4][2], const pg8::Unit& u, int wr, int wc, int fr, int fq) const {
        const int row0 = u.pm * 256 + wr * 64 + fr, col0 = u.pn * 256 + wc * 32 + 8 * fq;
#pragma unroll
        for (int ai = 0; ai < 2; ++ai)
#pragma unroll
            for (int m = 0; m < 4; ++m) {
                const int row = row0 + ai * 128 + m * 16; const size_t off = (size_t)row * D + col0; float ss = 0.f;
#pragma unroll
                for (int bj = 0; bj < 2; ++bj) {
                    const f32x4 r0 = *(const f32x4*)(base + off + bj * 128), r1 = *(const f32x4*)(base + off + bj * 128 + 4);
                    const f32x4 v0 = r0 + acc[ai][bj][m][0] * alpha, v1 = r1 + acc[ai][bj][m][1] * alpha;
                    *(f32x4*)(out + off + bj * 128) = v0; *(f32x4*)(out + off + bj * 128 + 4) = v1;
                    if (WB) *(v4u*)(hb + off + bj * 128) = pack8(v0, v1);
                    if (SS) ss += ((v0[0] * v0[0] + v0[1] * v0[1]) + (v0[2] * v0[2] + v0[3] * v0[3])) + ((v1[0] * v1[0] + v1[1] * v1[1]) + (v1[2] * v1[2] + v1[3] * v1[3]));
                }
                if (SS) { ss += __shfl_xor(ss, 16); ss += __shfl_xor(ss, 32); if (fq == 0) ssp[(size_t)row * 16 + u.pn * 4 + wc] = ss; }
                asm volatile("" ::: "memory");
            }
    }
};
struct EpiZin {
    static constexpr bool PERM = true, DUAL = false;
    bf16* Z; const float* ssp;
    __device__ __forceinline__ void operator()(pg8::f32x4 (&acc)[2][2][4][2], const pg8::Unit& u, int wr, int wc, int fr, int fq) const {
        const int row0 = u.pm * 256 + wr * 64 + fr; const int type = u.pn >> 3;
        const int cpair = (u.pn & 7) * 128 + wc * 32 + 8 * fq, cb = (u.pn - 24) * 256 + wc * 32 + 8 * fq;
#pragma unroll
        for (int ai = 0; ai < 2; ++ai)
#pragma unroll
            for (int m = 0; m < 4; ++m) {
                const int row = row0 + ai * 128 + m * 16; const float rs = row_rstd(ssp, row, fq);
                const f32x4 p0 = acc[ai][0][m][0] * rs, p1 = acc[ai][0][m][1] * rs, q0 = acc[ai][1][m][0] * rs, q1 = acc[ai][1][m][1] * rs;
                if (type == 0) {
                    f32x4 o0, o1;
#pragma unroll
                    for (int j = 0; j < 4; ++j) { o0[j] = p0[j] * sigmoidf_(q0[j]); o1[j] = p1[j] * sigmoidf_(q1[j]); }
                    *(v4u*)(Z + (size_t)row * D + cpair) = pack8(o0, o1);
                } else if (type == 1) {
                    *(v4u*)(Z + ZS + (size_t)row * D + cpair) = pack8(p0 * q0, p1 * q1);
                } else if (type == 2) {
                    f32x4 r0, r1, s0, s1;
#pragma unroll
                    for (int j = 0; j < 4; ++j) {
                        const float ea0 = fast_exp(-fminf(fmaxf(p0[j], -60.f), 60.f)), eb0 = fast_exp(-fminf(fmaxf(q0[j], -60.f), 60.f));
                        const float ea1 = fast_exp(-fminf(fmaxf(p1[j], -60.f), 60.f)), eb1 = fast_exp(-fminf(fmaxf(q1[j], -60.f), 60.f));
                        s0[j] = fast_rcp(1.f + eb0); s1[j] = fast_rcp(1.f + eb1);
                        r0[j] = (1.f + eb0) * fast_rcp(1.f + ea0); r1[j] = (1.f + eb1) * fast_rcp(1.f + ea1);
                    }
                    *(v4u*)(Z + 3 * ZS + (size_t)row * D + cpair) = pack8(r0, r1);
                    *(v4u*)(Z + 4 * ZS + (size_t)row * D + cpair) = pack8(s0, s1);
                } else {
                    *(v4u*)(Z + 2 * ZS + (size_t)row * D + cb) = pack8(p0, p1);
                    *(v4u*)(Z + 2 * ZS + (size_t)row * D + cb + 128) = pack8(q0, q1);
                }
            }
    }
};
struct EpiMix {
    static constexpr bool PERM = true, DUAL = true;
    const bf16* ratio; const bf16* sgb; bf16* O;
    __device__ __forceinline__ void mid(pg8::f32x4 (&acc)[2][2][4][2], const pg8::Unit& u, int wr, int wc, int fr, int fq) const {
        const int row0 = u.pm * 256 + wr * 64 + fr, col0 = u.pn * 256 + wc * 32 + 8 * fq;
#pragma unroll
        for (int ai = 0; ai < 2; ++ai)
#pragma unroll
            for (int m = 0; m < 4; ++m) {
                const size_t off = (size_t)(row0 + ai * 128 + m * 16) * D + col0;
#pragma unroll
                for (int bj = 0; bj < 2; ++bj) { const v4u w = *(const v4u*)(ratio + off + bj * 128); f32x4 a, b; unpack8(w, a, b); acc[ai][bj][m][0] *= a; acc[ai][bj][m][1] *= b; }
                if (m & 1) asm volatile("" ::: "memory");
            }
    }
    __device__ __forceinline__ void operator()(pg8::f32x4 (&acc)[2][2][4][2], const pg8::Unit& u, int wr, int wc, int fr, int fq) const {
        const int row0 = u.pm * 256 + wr * 64 + fr, col0 = u.pn * 256 + wc * 32 + 8 * fq;
#pragma unroll
        for (int ai = 0; ai < 2; ++ai)
#pragma unroll
            for (int m = 0; m < 4; ++m) {
                const size_t off = (size_t)(row0 + ai * 128 + m * 16) * D + col0;
#pragma unroll
                for (int bj = 0; bj < 2; ++bj) { const v4u w = *(const v4u*)(sgb + off + bj * 128); f32x4 a, b; unpack8(w, a, b);
                    *(v4u*)(O + off + bj * 128) = pack8(acc[ai][bj][m][0] * a, acc[ai][bj][m][1] * b); }
                if (m & 1) asm volatile("" ::: "memory");
            }
    }
};

__device__ __forceinline__ float wave_sum(float v) {
#pragma unroll
    for (int o = 1; o < 64; o <<= 1) v += __shfl_xor(v, o);
    return v;
}
__device__ __forceinline__ void p0_transpose_item(const float* W, const float* gain, int K, int N, bf16* WT, int k0, int n0, int drow, LAS float* scr, int lane) {
#pragma unroll 8
    for (int i = 0; i < 32; ++i) { const int kk = 2 * i + (lane >> 5); const float gk = gain ? gain[k0 + kk] : 1.0f; scr[kk * 33 + (lane & 31)] = W[(size_t)(k0 + kk) * N + n0 + (lane & 31)] * gk; }
    LDS_WAIT(); asm volatile("" ::: "memory");
    const int c = lane & 7;
#pragma unroll
    for (int j = 0; j < 4; ++j) { const int n = (lane >> 3) + 8 * j; const LAS float* s = scr + (8 * c) * 33 + n;
        v4u o; o.x = pk2(s[0 * 33], s[1 * 33]); o.y = pk2(s[2 * 33], s[3 * 33]); o.z = pk2(s[4 * 33], s[5 * 33]); o.w = pk2(s[6 * 33], s[7 * 33]);
        *(GAS v4u*)(WT + (size_t)(drow + n) * K + k0 + 8 * c) = o; }
    LDS_WAIT(); asm volatile("" ::: "memory");
}
__device__ __forceinline__ int dest_row(int mode, int n0) {
    if (mode == 0) return n0;
    if (mode == 1) return 256 * (n0 >> 7) + (n0 & 127);
    if (mode == 2) return 256 * (n0 >> 7) + 128 + (n0 & 127);
    const int s = n0 >> 10, j = n0 & 1023, pj = 256 * (j >> 7) + (j & 127);
    switch (s) {
        case 0: return pj;
        case 1: return pj + 128;
        case 2: return 6144 + j;
        case 3: return 2048 + pj;
        case 4: return 2048 + pj + 128;
        case 5: return 4096 + pj;
        default: return 4096 + pj + 128;
    }
}
__device__ __forceinline__ void p0_weight(const float* W, const float* gain, int K, int N, bf16* WT, int mode, int item, LAS float* scr, int lane) {
    const int nblk = N / 32, kb = item / nblk, nb = item % nblk;
    p0_transpose_item(W, gain, K, N, WT, 64 * kb, 32 * nb, dest_row(mode, 32 * nb), scr, lane);
}

struct Args { const float* in[20]; float* out; unsigned char* ws; int ph_lo, ph_hi, use_bar, pad; };

__global__ void __launch_bounds__(NWAVES * 64, 2) mk_fwd(Args args) {
    extern __shared__ __attribute__((aligned(16))) unsigned char lds_raw[];
    LAS unsigned char* lds = (LAS unsigned char*)lds_raw;
    volatile LAS unsigned* MISC = (volatile LAS unsigned*)(lds + MISC_OFF);
    const int tid = threadIdx.x, lane = tid & 63, wave = __builtin_amdgcn_readfirstlane(tid >> 6);
    const int G = gridDim.x; const int bx = blockIdx.x; const int vcu = (G % 8 == 0) ? (bx % 8) * (G / 8) + bx / 8 : bx;
    unsigned char* ws = args.ws;
    gu32* ctl = (gu32*)(ws + WS_CTL);
    const float* x = args.in[0];
    float* out = args.out;
    float* ssp1 = (float*)(ws + WS_SSP1); float* ssp2 = (float*)(ws + WS_SSP2); float* ssp3 = (float*)(ws + WS_SSP3);
    bf16* W1 = (bf16*)(ws + WS_W1); bf16* WD1 = (bf16*)(ws + WS_WD1); bf16* WIN = (bf16*)(ws + WS_WIN); bf16* WA = (bf16*)(ws + WS_WA); bf16* WB = (bf16*)(ws + WS_WB);
    bf16* WO = (bf16*)(ws + WS_WO); bf16* W2 = (bf16*)(ws + WS_W2); bf16* WD2 = (bf16*)(ws + WS_WD2);
    bf16* RA = (bf16*)(ws + WS_RA); bf16* Z = (bf16*)(ws + WS_Z); bf16* HID = (bf16*)(ws + WS_HID);

    for (int u = tid; u < (LDS_BYTES - LDSCTL_OFF) / 4; u += NWAVES * 64) ((LAS unsigned*)(lds + LDSCTL_OFF))[u] = 0u;
    __syncthreads();
    XcdBarrier bar; bar.bar = (unsigned*)(ctl + CW_BAR); bar.x = 0; bar.st = nullptr;
    if (args.use_bar) bar = xcd_barrier_post((unsigned*)(ctl + CW_BAR), MISC + 8);
    const int lo = args.ph_lo, hi = args.ph_hi;
#define IN(k) (lo <= (k) && (k) < hi)
#define SEAM(k) do { if (IN(k) && IN((k) + 1)) xcd_barrier(bar); } while (0)

    if (IN(0)) {
        LAS float* scr = (LAS float*)(lds + wave * 16384);
        const int gw = vcu * NWAVES + wave, NGW = G * NWAVES;
        constexpr int I_GU = (D / 64) * (FF / 32), I_DN = (FF / 64) * (D / 32), I_IN = (D / 64) * (DIN / 32), I_SQ = (D / 64) * (D / 32);
        constexpr int NITEMS = 4 * I_GU + 2 * I_DN + I_IN + 3 * I_SQ;
        for (int it = gw; it < NITEMS; it += NGW) {
            int r = it;
            if (r < I_GU) { p0_weight(args.in[2], args.in[1], D, FF, W1, 1, r, scr, lane); continue; } r -= I_GU;
            if (r < I_GU) { p0_weight(args.in[3], args.in[1], D, FF, W1, 2, r, scr, lane); continue; } r -= I_GU;
            if (r < I_DN) { p0_weight(args.in[4], nullptr, FF, D, WD1, 0, r, scr, lane); continue; } r -= I_DN;
            if (r < I_IN) { p0_weight(args.in[6], args.in[5], D, DIN, WIN, 3, r, scr, lane); continue; } r -= I_IN;
            if (r < I_SQ) { p0_weight(args.in[11], nullptr, D, D, WA, 0, r, scr, lane); continue; } r -= I_SQ;
            if (r < I_SQ) { p0_weight(args.in[13], nullptr, D, D, WB, 0, r, scr, lane); continue; } r -= I_SQ;
            if (r < I_SQ) { p0_weight(args.in[14], nullptr, D, D, WO, 0, r, scr, lane); continue; } r -= I_SQ;
            if (r < I_GU) { p0_weight(args.in[16], args.in[15], D, FF, W2, 1, r, scr, lane); continue; } r -= I_GU;
            if (r < I_GU) { p0_weight(args.in[17], args.in[15], D, FF, W2, 2, r, scr, lane); continue; } r -= I_GU;
            p0_weight(args.in[18], nullptr, FF, D, WD2, 0, r, scr, lane);
        }
        for (int m = gw; m < M; m += NGW) {
            const GAS f32x4* xr = (const GAS f32x4*)(x + (size_t)m * D) + lane; f32x4 v[4]; float s = 0.f;
#pragma unroll
            for (int j = 0; j < 4; ++j) { v[j] = xr[64 * j]; s += (v[j].x * v[j].x + v[j].y * v[j].y) + (v[j].z * v[j].z + v[j].w * v[j].w); }
            s = wave_sum(s);
            GAS v2u* o8 = (GAS v2u*)(RA + (size_t)m * D) + lane;
#pragma unroll
            for (int j = 0; j < 4; ++j) { v2u o; o.x = pk2(v[j].x, v[j].y); o.y = pk2(v[j].z, v[j].w); o8[64 * j] = o; }
            if (lane < 16) ssp1[(size_t)m * 16 + lane] = (lane == 0) ? s : 0.f;
        }
    }
    SEAM(0);
    if (IN(1)) {
        pg8::Gemm g{RA, W1, nullptr, nullptr, M, 2 * FF, D}; pg8::StaticOrder S; S.init(M, 2 * FF, G, bx);
        EpiSwiglu E{HID, ssp1};
        pg8::gemm_phase<EpiSwiglu, pg8::StaticOrder, PG8_ALIGN, PG8_SP2>(lds, g, S, E);
    }
    SEAM(1);
    if (IN(2)) {
        pg8::Gemm g{HID, WD1, nullptr, nullptr, M, D, FF}; pg8::StaticOrder S; S.init(M, D, G, bx);
        EpiResid<true, true> E{x, out, RA, ssp2, 0.5f};
        pg8::gemm_phase<EpiResid<true, true>, pg8::StaticOrder, PG8_ALIGN, PG8_SP2>(lds, g, S, E);
    }
    SEAM(2);
    if (IN(3)) {
        pg8::Gemm g{RA, WIN, nullptr, nullptr, M, DIN, D}; pg8::StaticOrder S; S.init(M, DIN, G, bx);
        EpiZin E{Z, ssp2};
        pg8::gemm_phase<EpiZin, pg8::StaticOrder, PG8_ALIGN, PG8_SP2>(lds, g, S, E);
    }
    SEAM(3);
    if (IN(4)) {
        const int c0 = 2 * tid;
        f32x2 wA[CA];
#pragma unroll
        for (int k = 0; k < CA; ++k) wA[k] = *(const f32x2*)(args.in[7] + (size_t)k * D + c0);
        const f32x2 cbias = *(const f32x2*)(args.in[8] + c0), lng = *(const f32x2*)(args.in[9] + c0), lnb = *(const f32x2*)(args.in[10] + c0);
        const f32x2 wB0 = *(const f32x2*)(args.in[12] + c0), wB1 = *(const f32x2*)(args.in[12] + D + c0), wB2 = *(const f32x2*)(args.in[12] + 2 * D + c0);
        const bf16* Z0 = Z; const bf16* Z1 = Z + ZS; bf16* Z2 = Z + 2 * ZS;
        LAS unsigned* tile32 = (LAS unsigned*)lds;
        LAS f32x2* P = (LAS f32x2*)(lds + 62 * 2048);
        LAS f32x2* Sx = (LAS f32x2*)(lds + 62 * 2048 + 1024);
        for (int tile = vcu; tile < M / 32; tile += G) {
            const int t0g = tile * 32, tin = t0g & (SEQ - 1);
            for (int i = tid; i < 62 * 128; i += NWAVES * 64) { const int j = i >> 7, ch = i & 127;
                v4u v = (v4u){0u, 0u, 0u, 0u}; if (tin - 30 + j >= 0) v = *(const GAS v4u*)(Z0 + (size_t)(t0g - 30 + j) * D + ch * 8);
                *(LAS v4u*)(lds + j * 2048 + ch * 16) = v; }
            __syncthreads();
            for (int grp = 0; grp < 2; ++grp) {
                f32x2 a[16];
#pragma unroll
                for (int tt = 0; tt < 16; ++tt) a[tt] = cbias;
#pragma unroll
                for (int r = 0; r < 46; ++r) {
                    const unsigned xv = tile32[(grp * 16 + r) * 512 + tid]; const f32x2 xf = (f32x2){bflo(xv), bfhi(xv)};
#pragma unroll
                    for (int tt = 0; tt < 16; ++tt) { const int k = r - tt; if (k >= 0 && k < CA) a[tt] = xf * wA[k] + a[tt]; }
                }
                float v[32];
#pragma unroll
                for (int tt = 0; tt < 16; ++tt) { v[2 * tt] = a[tt].x + a[tt].y; v[2 * tt + 1] = a[tt].x * a[tt].x + a[tt].y * a[tt].y; }
#pragma unroll
                for (int st = 0; st < 5; ++st) {
                    const int o = 1 << st, n = 16 >> st; const bool up = (lane & o) != 0;
#pragma unroll
                    for (int i = 0; i < n; ++i) { const float lo_ = v[i], hi_ = v[i + n]; const float send = up ? lo_ : hi_, keep = up ? hi_ : lo_; v[i] = keep + __shfl_xor(send, o); }
                }
                v[0] += __shfl_xor(v[0], 32);
                {
                    const int idx = ((lane & 1) << 4) | ((lane & 2) << 2) | (lane & 4) | ((lane & 8) >> 2) | ((lane & 16) >> 4);
                    if (lane < 32) ((LAS float*)P)[wave * 32 + idx] = v[0];
                }
                __syncthreads();
                if (tid < 16) { float s = 0.f, q = 0.f;
#pragma unroll
                    for (int w = 0; w < 8; ++w) { const f32x2 p = P[w * 16 + tid]; s += p.x; q += p.y; }
                    const float mean = s * (1.0f / D), var = q * (1.0f / D) - mean * mean; Sx[tid] = (f32x2){mean, rsqrtf(var + EPS)}; }
                __syncthreads();
#pragma unroll
                for (int tt = 0; tt < 16; ++tt) {
                    const f32x2 st = Sx[tt]; const f32x2 y = (a[tt] - st.x) * st.y * lng + lnb;
                    const float o0 = y.x * sigmoidf_(y.x), o1 = y.y * sigmoidf_(y.y);
                    *(GAS unsigned*)(RA + (size_t)(t0g + grp * 16 + tt) * D + c0) = pg8::cvt_pk_bf16(o0, o1);
                }
            }
            {
                f32x2 xm2 = (f32x2){0.f, 0.f}, xm1 = (f32x2){0.f, 0.f};
                if (tin > 0) { const unsigned u2 = *(const GAS unsigned*)(Z1 + (size_t)(t0g - 2) * D + c0), u1 = *(const GAS unsigned*)(Z1 + (size_t)(t0g - 1) * D + c0);
                    xm2 = (f32x2){bflo(u2), bfhi(u2)}; xm1 = (f32x2){bflo(u1), bfhi(u1)}; }
#pragma unroll 8
                for (int tt = 0; tt < 32; ++tt) {
                    const size_t off = (size_t)(t0g + tt) * D + c0;
                    const unsigned ux = *(const GAS unsigned*)(Z1 + off), ub = *(const GAS unsigned*)(Z2 + off);
                    const f32x2 x0 = (f32x2){bflo(ux), bfhi(ux)}, bb = (f32x2){bflo(ub), bfhi(ub)};
                    const f32x2 vv = (wB0 * xm2 + wB1 * xm1 + wB2 * x0) * bb;
                    *(GAS unsigned*)(Z2 + off) = pg8::cvt_pk_bf16(vv.x, vv.y);
                    xm2 = xm1; xm1 = x0;
                }
            }
            __syncthreads();
        }
    }
    SEAM(4);
    if (IN(5)) {
        pg8::Gemm g{RA, WA, Z + 2 * ZS, WB, M, D, D}; pg8::DualOrder S; S.s.init(M, D, G, bx);
        EpiMix E{Z + 3 * ZS, Z + 4 * ZS, Z};
        pg8::gemm_phase<EpiMix, pg8::DualOrder, PG8_ALIGN, PG8_SP2>(lds, g, S, E);
    }
    SEAM(5);
    if (IN(6)) {
        pg8::Gemm g{Z, WO, nullptr, nullptr, M, D, D}; pg8::StaticOrder S; S.init(M, D, G, bx);
        EpiResid<true, true> E{out, out, RA, ssp3, 1.0f};
        pg8::gemm_phase<EpiResid<true, true>, pg8::StaticOrder, PG8_ALIGN, PG8_SP2>(lds, g, S, E);
    }
    SEAM(6);
    if (IN(7)) {
        pg8::Gemm g{RA, W2, nullptr, nullptr, M, 2 * FF, D}; pg8::StaticOrder S; S.init(M, 2 * FF, G, bx);
        EpiSwiglu E{HID, ssp3};
        pg8::gemm_phase<EpiSwiglu, pg8::StaticOrder, PG8_ALIGN, PG8_SP2>(lds, g, S, E);
    }
    SEAM(7);
    if (IN(8)) {
        pg8::Gemm g{HID, WD2, nullptr, nullptr, M, D, FF}; pg8::StaticOrder S; S.init(M, D, G, bx);
        EpiResid<false, false> E{out, out, nullptr, nullptr, 0.5f};
        pg8::gemm_phase<EpiResid<false, false>, pg8::StaticOrder, PG8_ALIGN, PG8_SP2>(lds, g, S, E);
    }
    SEAM(8);
    if (IN(9)) {
        const int gw = vcu * NWAVES + wave, NGW = G * NWAVES;
        const GAS f32x4* gf = (const GAS f32x4*)args.in[19] + lane;
        f32x4 gv[4];
#pragma unroll
        for (int j = 0; j < 4; ++j) gv[j] = gf[64 * j];
        for (int m = gw; m < M; m += NGW) {
            GAS f32x4* row = (GAS f32x4*)(out + (size_t)m * D) + lane; f32x4 v[4]; float s = 0.f;
#pragma unroll
            for (int j = 0; j < 4; ++j) { v[j] = row[64 * j]; s += (v[j].x * v[j].x + v[j].y * v[j].y) + (v[j].z * v[j].z + v[j].w * v[j].w); }
            const float rstd = rsqrtf(wave_sum(s) * (1.0f / D) + EPS);
#pragma unroll
            for (int j = 0; j < 4; ++j) row[64 * j] = v[j] * rstd * gv[j];
        }
    }
#undef IN
#undef SEAM
}

extern "C" void kernel_launch(void* const* d_in, const int* in_sizes, int n_in, void* d_out, int out_size, void* d_ws, size_t ws_size, hipStream_t stream) {
    static int grid = 0;
    if (grid == 0) {
        if (n_in != 20 || in_sizes[0] != M * D || out_size != M * D || ws_size < WS_END) {
            fprintf(stderr, "kernel_launch: built for 20 inputs, x/out of %d floats, >= %zu bytes of workspace; got n_in %d, in0 %d, out %d, ws %zu; nothing launched\n", M * D, (size_t)WS_END, n_in, n_in > 0 ? in_sizes[0] : -1, out_size, ws_size);
            grid = -1; return; }
        int dev = 0, cus = 0, per_cu = 0;
        if (hipGetDevice(&dev) != hipSuccess || hipDeviceGetAttribute(&cus, hipDeviceAttributeMultiprocessorCount, dev) != hipSuccess) { fprintf(stderr, "kernel_launch: device query failed\n"); grid = -1; return; }
        if (hipFuncSetAttribute((const void*)mk_fwd, hipFuncAttributeMaxDynamicSharedMemorySize, LDS_BYTES) != hipSuccess) { fprintf(stderr, "kernel_launch: hipFuncSetAttribute failed\n"); grid = -1; return; }
        if (hipOccupancyMaxActiveBlocksPerMultiprocessor(&per_cu, (const void*)mk_fwd, NWAVES * 64, LDS_BYTES) != hipSuccess || per_cu < 1) { fprintf(stderr, "kernel_launch: occupancy query says %d blocks per CU\n", per_cu); per_cu = 1; }
        (void)hipGetLastError();
        grid = cus;
        if (grid % 8 != 0 || (M / 256) * 4 % grid != 0) fprintf(stderr, "kernel_launch: note: grid %d does not divide the tile counts evenly\n", grid);
    }
    if (grid < 0) return;
    if (hipMemsetAsync((char*)d_ws + WS_CTL, 0, CTL_ZERO_BYTES, stream) != hipSuccess) { fprintf(stderr, "kernel_launch: memset failed\n"); return; }
    Args a{};
    for (int i = 0; i < 20; ++i) a.in[i] = (const float*)d_in[i];
    a.out = (float*)d_out; a.ws = (unsigned char*)d_ws;
    if (MK_N_LAUNCHES == 1) {
        a.ph_lo = 0; a.ph_hi = N_PHASES; a.use_bar = 1;
        hipLaunchKernelGGL(mk_fwd, dim3(grid), dim3(NWAVES * 64), LDS_BYTES, stream, a);
    } else {
        for (int p = 0; p < N_PHASES; ++p) { a.ph_lo = p; a.ph_hi = p + 1; a.use_bar = 0;
            hipLaunchKernelGGL(mk_fwd, dim3(grid), dim3(NWAVES * 64), LDS_BYTES, stream, a); }
    }
    const hipError_t le = hipPeekAtLastError();
    if (le != hipSuccess) fprintf(stderr, "kernel_launch: launch failed: %s\n", hipGetErrorName(le));
}
```

```cpp
#include <hip/hip_runtime.h>
#include <cstdio>
#include <cstdint>

#ifndef MK_N_LAUNCHES
#define MK_N_LAUNCHES 1
#endif

namespace pg8 {
#define PG8_LAS __attribute__((address_space(3)))
typedef unsigned short bf16_t;
typedef short bf16x8 __attribute__((ext_vector_type(8)));
typedef float f32x4 __attribute__((ext_vector_type(4)));
typedef unsigned u32x4 __attribute__((ext_vector_type(4)));
constexpr int BM = 256, BK = 64, HALF = 128, HTB = HALF * BK * 2  , STAGE_BYTES = 8 * HTB, NXCD = 8, WGM = 8;

__host__ __device__ __forceinline__ int lds_byte(int r, int c) { const int st = (r >> 4) * 2 + (c >> 5), rr = r & 15, cc = c & 31, ob = rr * 64 + cc * 2; return st * 1024 + (ob ^ (((ob >> 9) & 1) << 5)); }
__host__ __device__ __forceinline__ void stage_rc(int b, int& R, int& C) { const int st = b / 1024, sb = b % 1024, swz = sb ^ (((sb >> 9) & 1) << 5); R = (st >> 1) * 16 + swz / 64; C = (st & 1) * 32 + (swz % 64) / 2; }
__host__ __device__ __forceinline__ int perm32(int rho) { const int n = rho >> 4, i = rho & 15; return 8 * (i >> 2) + 4 * n + (i & 3); }

struct Unit { int pm, pn, sel; };
struct Gemm { const bf16_t* A; const bf16_t* Bt; const bf16_t* A2; const bf16_t* Bt2; int M, N, K; };

struct StaticOrder {
    int nM, nN, nwg, G, c;
    __device__ void init(int M, int N, int G_, int c_) { nM = M / BM; nN = N / BM; nwg = nM * nN; G = G_; c = c_; }
    __device__ bool next(int i, Unit& u) const {
        const long L = (long)i * G + c; if (L >= nwg) return false;
        int wgid = (int)L; { const int q = nwg / NXCD, r = nwg % NXCD, xcd = wgid % NXCD, off = wgid / NXCD; wgid = (xcd < r ? xcd * (q + 1) : r * (q + 1) + (xcd - r) * q) + off; }
        const int nig = WGM * nN, gid = wgid / nig, fm = gid * WGM, gsz = (nM - fm) < WGM ? (nM - fm) : WGM;
        u.pm = fm + ((wgid % nig) % gsz); u.pn = (wgid % nig) / gsz; u.sel = 0; return true;
    }
};
struct DualOrder {
    StaticOrder s;
    __device__ bool next(int j, Unit& u) const { if (!s.next(j >> 1, u)) return false; u.sel = j & 1; return true; }
};

__device__ __forceinline__ unsigned cvt_pk_bf16(float lo, float hi) { unsigned r; asm volatile("v_cvt_pk_bf16_f32 %0, %1, %2" : "=v"(r) : "v"(lo), "v"(hi)); return r; }

template <class Epi, class Sched, bool ALIGN_EPI = false, bool SP2 = false>
__device__ __forceinline__ void gemm_phase(PG8_LAS unsigned char* lds, const Gemm g, const Sched& S, const Epi& E) {
    const int tid = threadIdx.x, wid = __builtin_amdgcn_readfirstlane(tid >> 6), lane = tid & 63, wr = wid >> 2, wc = wid & 3, fr = lane & 15, fq = lane >> 4;
    const int K = g.K, nt = K / BK;
    unsigned voffA[2], voffB[2];
#pragma unroll
    for (int i = 0; i < 2; ++i) { int R, C; stage_rc(tid * 16 + i * 8192, R, C); const int Rb = Epi::PERM ? ((R & ~31) + perm32(R & 31)) : R;
        voffA[i] = (unsigned)(R * K + C) * 2u; voffB[i] = (unsigned)(Rb * K + C) * 2u; }
    const size_t kstep = (size_t)(BK * 2);
    const size_t hstep = (size_t)HALF * K * 2;
    const size_t tstep = 2 * hstep;
    const unsigned ldsw = (unsigned)wid * 1024u;
    const int aoff = lds_byte(wr * 64 + fr, fq * 8), boff = lds_byte(wc * 32 + fr, fq * 8);
#define PG8_SA(b, h) (((b) * 2 + (h)) * HTB)
#define PG8_SB(b, h) ((4 + (b) * 2 + (h)) * HTB)
#define PG8_STAGE(bufoff, gbase, voff) do { _Pragma("unroll") for (int _i = 0; _i < 2; ++_i) \
        __builtin_amdgcn_global_load_lds((const unsigned*)((const char*)(gbase) + (voff)[_i]), (PG8_LAS unsigned*)(lds + (bufoff) + ldsw + _i * 8192), 16, 0, 0); } while (0)
#define PG8_LDA(dst, b, h) do { _Pragma("unroll") for (int m = 0; m < 4; ++m) _Pragma("unroll") for (int k = 0; k < 2; ++k) dst[m][k] = *(const PG8_LAS bf16x8*)(lds + PG8_SA(b, h) + aoff + m * 2048 + k * 1024); } while (0)
#define PG8_LDB(dst, b, h) do { _Pragma("unroll") for (int n = 0; n < 2; ++n) _Pragma("unroll") for (int k = 0; k < 2; ++k) dst[n][k] = *(const PG8_LAS bf16x8*)(lds + PG8_SB(b, h) + boff + n * 2048 + k * 1024); } while (0)
#define PG8_MMA(ai, bj, At, Bt) do { __builtin_amdgcn_s_setprio(1); _Pragma("unroll") for (int m = 0; m < 4; ++m) _Pragma("unroll") for (int n = 0; n < 2; ++n) _Pragma("unroll") for (int k = 0; k < 2; ++k) \
        acc[ai][bj][m][n] = __builtin_amdgcn_mfma_f32_16x16x32_bf16(Bt[n][k], At[m][k], acc[ai][bj][m][n], 0, 0, 0); __builtin_amdgcn_s_setprio(0); } while (0)
#define PG8_WAIT_V(n) asm volatile("s_waitcnt vmcnt(" #n ")" ::: "memory")
#define PG8_WAIT_L(n) asm volatile("s_waitcnt lgkmcnt(" #n ")" ::: "memory")
#define PG8_BAR __builtin_amdgcn_s_barrier()
#define PG8_SCHED __builtin_amdgcn_sched_barrier(0)
#define PG8_ABASE(u) ((const char*)((u).sel ? g.A2 : g.A) + (size_t)(u).pm * tstep)
#define PG8_BBASE(u) ((const char*)((u).sel ? g.Bt2 : g.Bt) + (size_t)(u).pn * tstep)
    Unit cur, nxt; int ui = 0;
    if (!S.next(0, cur)) return;
    f32x4 acc[2][2][4][2];
#pragma unroll
    for (int a = 0; a < 2; ++a)
#pragma unroll
        for (int b = 0; b < 2; ++b)
#pragma unroll
            for (int m = 0; m < 4; ++m)
#pragma unroll
                for (int n = 0; n < 2; ++n) acc[a][b][m][n] = (f32x4){0.f, 0.f, 0.f, 0.f};
    bf16x8 At[4][2], B0[2][2], B1[2][2];
    const char* cA = PG8_ABASE(cur); const char* cB = PG8_BBASE(cur);
    if constexpr (SP2) {
        PG8_STAGE(PG8_SB(0, 0), cB, voffB); PG8_STAGE(PG8_SB(0, 1), cB + hstep, voffB); PG8_STAGE(PG8_SA(0, 0), cA, voffA); PG8_STAGE(PG8_SA(0, 1), cA + hstep, voffA);
        if (wr == 1) PG8_BAR;
        PG8_WAIT_V(2); PG8_BAR;
        PG8_STAGE(PG8_SB(1, 0), cB + kstep, voffB); PG8_STAGE(PG8_SA(1, 0), cA + kstep, voffA); PG8_STAGE(PG8_SB(1, 1), cB + hstep + kstep, voffB);
        PG8_WAIT_V(6); PG8_BAR;
    } else {
        PG8_STAGE(PG8_SB(0, 0), cB, voffB); PG8_STAGE(PG8_SA(0, 0), cA, voffA); PG8_STAGE(PG8_SB(0, 1), cB + hstep, voffB); PG8_STAGE(PG8_SA(0, 1), cA + hstep, voffA);
        if (wr == 1) PG8_BAR;
        PG8_WAIT_V(4); PG8_BAR;
        PG8_STAGE(PG8_SB(1, 0), cB + kstep, voffB); PG8_STAGE(PG8_SA(1, 0), cA + kstep, voffA); PG8_STAGE(PG8_SB(1, 1), cB + hstep + kstep, voffB);
        PG8_WAIT_V(6); PG8_BAR;
    }
    for (;;) {
        const bool has_next = S.next(ui + 1, nxt);
        const char* nA = has_next ? PG8_ABASE(nxt) : cA; const char* nB = has_next ? PG8_BBASE(nxt) : cB;
        for (int t = 0; t < nt; t += 2) {
            const bool last = (t == nt - 2);
            const char* a1 = cA + (size_t)(t + 1) * kstep;
            const char* a2 = last ? nA : cA + (size_t)(t + 2) * kstep; const char* b2 = last ? nB : cB + (size_t)(t + 2) * kstep;
            const char* a3 = a2 + kstep; const char* b3 = b2 + kstep;
            if constexpr (SP2) {
            PG8_LDB(B0, 0, 0); PG8_LDB(B1, 0, 1); PG8_SCHED; PG8_LDA(At, 0, 0); PG8_STAGE(PG8_SA(1, 1), a1 + hstep, voffA);
            PG8_WAIT_V(8); PG8_WAIT_L(0); PG8_BAR; PG8_MMA(0, 0, At, B0); PG8_MMA(0, 1, At, B1); PG8_BAR; PG8_SCHED;
            PG8_LDA(At, 0, 1); PG8_STAGE(PG8_SB(0, 0), b2, voffB); PG8_STAGE(PG8_SB(0, 1), b2 + hstep, voffB); PG8_STAGE(PG8_SA(0, 0), a2, voffA);
            PG8_WAIT_V(8); PG8_WAIT_L(0); PG8_BAR; PG8_MMA(1, 0, At, B0); PG8_MMA(1, 1, At, B1); PG8_BAR; PG8_SCHED;
            PG8_LDB(B0, 1, 0); PG8_LDB(B1, 1, 1); PG8_SCHED; PG8_LDA(At, 1, 0); PG8_STAGE(PG8_SA(0, 1), a2 + hstep, voffA);
            PG8_WAIT_V(8); PG8_WAIT_L(0); PG8_BAR; PG8_MMA(0, 0, At, B0); PG8_MMA(0, 1, At, B1); PG8_BAR; PG8_SCHED;
            PG8_LDA(At, 1, 1); PG8_STAGE(PG8_SB(1, 0), b3, voffB); PG8_STAGE(PG8_SB(1, 1), b3 + hstep, voffB); PG8_STAGE(PG8_SA(1, 0), a3, voffA);
            PG8_WAIT_V(8); PG8_WAIT_L(0); PG8_BAR; PG8_MMA(1, 0, At, B0); PG8_MMA(1, 1, At, B1); PG8_BAR; PG8_SCHED;
            } else {
            PG8_LDB(B0, 0, 0); PG8_SCHED; PG8_LDA(At, 0, 0); PG8_STAGE(PG8_SA(1, 1), a1 + hstep, voffA);
            PG8_WAIT_L(8); PG8_BAR; PG8_WAIT_L(0); PG8_MMA(0, 0, At, B0); PG8_BAR; PG8_SCHED;
            PG8_LDB(B1, 0, 1); PG8_STAGE(PG8_SB(0, 0), b2, voffB);
            PG8_BAR; PG8_WAIT_L(0); PG8_MMA(0, 1, At, B1); PG8_BAR;
            PG8_LDA(At, 0, 1); PG8_STAGE(PG8_SA(0, 0), a2, voffA);
            PG8_BAR; PG8_WAIT_L(0); PG8_MMA(1, 0, At, B0); PG8_BAR; PG8_SCHED;
            PG8_STAGE(PG8_SB(0, 1), b2 + hstep, voffB);
            PG8_WAIT_V(6); PG8_BAR; PG8_MMA(1, 1, At, B1); PG8_BAR;
            PG8_LDB(B0, 1, 0); PG8_SCHED; PG8_LDA(At, 1, 0); PG8_STAGE(PG8_SA(0, 1), a2 + hstep, voffA);
            PG8_WAIT_L(8); PG8_BAR; PG8_WAIT_L(0); PG8_MMA(0, 0, At, B0); PG8_BAR; PG8_SCHED;
            PG8_LDB(B1, 1, 1); PG8_STAGE(PG8_SB(1, 0), b3, voffB);
            PG8_BAR; PG8_WAIT_L(0); PG8_MMA(0, 1, At, B1); PG8_BAR;
            PG8_LDA(At, 1, 1); PG8_STAGE(PG8_SA(1, 0), a3, voffA);
            PG8_BAR; PG8_WAIT_L(0); PG8_MMA(1, 0, At, B0); PG8_BAR; PG8_SCHED;
            PG8_STAGE(PG8_SB(1, 1), b3 + hstep, voffB);
            PG8_WAIT_V(6); PG8_BAR; PG8_MMA(1, 1, At, B1); PG8_BAR;
            }
        }
        if constexpr (ALIGN_EPI) { if (wr == 0) PG8_BAR; }
        bool keep = false;
        if constexpr (Epi::DUAL) { if (cur.sel == 0) { E.mid(acc, cur, wr, wc, fr, fq); keep = true; } else E(acc, cur, wr, wc, fr, fq); }
        else E(acc, cur, wr, wc, fr, fq);
        if (!has_next) break;
        if (!keep) {
#pragma unroll
        for (int a = 0; a < 2; ++a)
#pragma unroll
            for (int b = 0; b < 2; ++b)
#pragma unroll
                for (int m = 0; m < 4; ++m)
#pragma unroll
                    for (int n = 0; n < 2; ++n) acc[a][b][m][n] = (f32x4){0.f, 0.f, 0.f, 0.f};
        }
        cur = nxt; cA = nA; cB = nB; ++ui;
        if constexpr (ALIGN_EPI) { if (wr == 1) PG8_BAR; }
    }
    PG8_WAIT_V(0);
    if constexpr (!ALIGN_EPI) { if (wr == 0) PG8_BAR; }
    PG8_BAR;
#undef PG8_SA
#undef PG8_SB
#undef PG8_STAGE
#undef PG8_LDA
#undef PG8_LDB
#undef PG8_MMA
#undef PG8_WAIT_V
#undef PG8_WAIT_L
#undef PG8_BAR
#undef PG8_SCHED
#undef PG8_ABASE
#undef PG8_BBASE
}
}

#ifndef PG8_SP2
#define PG8_SP2 true
#endif
#ifndef PG8_ALIGN
#define PG8_ALIGN true
#endif

constexpr int NWAVES = 8;
constexpr int BATCH = 8, SEQ = 4096, D = 1024, FF = 2816, DIN = 7168, CA = 31, CB = 3;
constexpr int M = BATCH * SEQ;
constexpr float EPS = 1e-6f;
constexpr int N_PHASES = 10;

constexpr size_t MiB = 1u << 20;
constexpr size_t WS_CTL = 0, CTL_ZERO_BYTES = 64 * 1024;
constexpr size_t WS_SSP1 = 1 * MiB, WS_SSP2 = 3 * MiB, WS_SSP3 = 5 * MiB;
constexpr size_t WS_W1 = 8 * MiB, WS_WD1 = 19 * MiB, WS_WIN = 25 * MiB, WS_WA = 39 * MiB, WS_WB = 41 * MiB, WS_WO = 43 * MiB, WS_W2 = 45 * MiB, WS_WD2 = 56 * MiB;
constexpr size_t WS_RA = 64 * MiB;
constexpr size_t WS_Z = 128 * MiB;
constexpr size_t WS_HID = 128 * MiB;
constexpr size_t WS_END = 448 * MiB;
constexpr size_t ZS = (size_t)M * D;
static_assert(WS_W1 + (size_t)2 * FF * D * 2 <= WS_WD1 && WS_WD1 + (size_t)D * FF * 2 <= WS_WIN && WS_WIN + (size_t)DIN * D * 2 <= WS_WA && WS_W2 + (size_t)2 * FF * D * 2 <= WS_WD2 && WS_WD2 + (size_t)D * FF * 2 <= WS_RA, "weights map");
static_assert(WS_HID + (size_t)M * FF * 2 <= WS_Z + 3 * ZS * 2 && WS_Z + 5 * ZS * 2 <= WS_END, "activation map");
constexpr int CW_BAR = 1024;

constexpr int RING_BYTES = 131072;
constexpr int LDSCTL_OFF = RING_BYTES, MISC_OFF = LDSCTL_OFF + 320;
constexpr int LDS_BYTES = 147456;

#define GAS __attribute__((address_space(1)))
#define LAS __attribute__((address_space(3)))
typedef unsigned short bf16;
typedef unsigned v4u __attribute__((ext_vector_type(4)));
typedef unsigned v2u __attribute__((ext_vector_type(2)));
typedef float f32x4 __attribute__((ext_vector_type(4)));
typedef float f32x2 __attribute__((ext_vector_type(2)));
typedef GAS unsigned gu32;
#define RLX_AGENT __ATOMIC_RELAXED, __HIP_MEMORY_SCOPE_AGENT
#define LDS_WAIT() asm volatile("s_waitcnt lgkmcnt(0)" ::: "memory")
#define VM_WAIT() asm volatile("s_waitcnt vmcnt(0)" ::: "memory")
__device__ __forceinline__ unsigned f2bf(float f) { unsigned u = __builtin_bit_cast(unsigned, f); return (u + 0x7fffu + ((u >> 16) & 1u)) >> 16; }
__device__ __forceinline__ unsigned pk2(float lo, float hi) { return f2bf(lo) | (f2bf(hi) << 16); }
__device__ __forceinline__ float bflo(unsigned x) { return __builtin_bit_cast(float, x << 16); }
__device__ __forceinline__ float bfhi(unsigned x) { return __builtin_bit_cast(float, x & 0xffff0000u); }
__device__ __forceinline__ float fast_exp(float x) { return __builtin_amdgcn_exp2f(x * 1.44269504089f); }
__device__ __forceinline__ float fast_rcp(float x) { return __builtin_amdgcn_rcpf(x); }
__device__ __forceinline__ float sigmoidf_(float x) { return fast_rcp(1.0f + fast_exp(-x)); }

#define XB_TMO      128
#define XB_XCNT(j)  (256  + 64 * (j))
#define XB_XSUB(j)  (1280 + 64 * (j))
#define XB_XGEN(j)  (2304 + 64 * (j))
#define XB_TOP      3328
#define XB_TOPGEN   3392
#define XCD_BAR_WORDS 3456
#define XB_SPIN_CAP (1u << 18)
static_assert((CW_BAR + XCD_BAR_WORDS) * 4 <= (int)CTL_ZERO_BYTES, "barrier words inside the memset region");
__device__ __forceinline__ unsigned xb_ld(unsigned* p)              { return __hip_atomic_load(p, __ATOMIC_RELAXED, __HIP_MEMORY_SCOPE_AGENT); }
__device__ __forceinline__ unsigned xb_add(unsigned* p, unsigned v) { return __hip_atomic_fetch_add(p, v, __ATOMIC_RELAXED, __HIP_MEMORY_SCOPE_AGENT); }
__device__ __forceinline__ unsigned xb_xcc_id() { return (unsigned)__builtin_amdgcn_s_getreg((3 << 11) | 20) & 0xFu; }
#define XB_SPIN(cond, bar) do { unsigned _sp = 0; while (cond) { __builtin_amdgcn_s_sleep(1); \
    if ((++_sp & 255u) == 0u) { if (xb_ld(&(bar)[XB_TMO])) break; if (_sp > XB_SPIN_CAP) { atomicAdd(&(bar)[XB_TMO], 1u); break; } } } } while (0)
struct XcdBarrier { unsigned* bar; unsigned x; volatile LAS unsigned* st; };
__device__ __forceinline__ XcdBarrier xcd_barrier_post(unsigned* bar, volatile LAS unsigned* st) {
    XcdBarrier b; b.bar = bar; b.x = xb_xcc_id(); b.st = st;
    if (threadIdx.x == 0) (void)xb_add(&bar[XB_XCNT(b.x)], 1u);
    return b;
}
__device__ __forceinline__ void xcd_barrier_complete(unsigned* bar, unsigned x, unsigned& nloc, unsigned& nx) {
    const unsigned G = gridDim.x * gridDim.y * gridDim.z;
    unsigned sum, cnt, mine, sp = 0u;
    for (;;) {
        sum = 0u; cnt = 0u; mine = 0u;
#pragma unroll
        for (unsigned j = 0; j < 16; ++j) { const unsigned c = xb_ld(&bar[XB_XCNT(j)]); sum += c; cnt += (c > 0u) ? 1u : 0u; mine = (j == x) ? c : mine; }
        if (sum == G) break;
        __builtin_amdgcn_s_sleep(1);
        if ((++sp & 255u) == 0u) { if (xb_ld(&bar[XB_TMO])) break; if (sp > XB_SPIN_CAP) { atomicAdd(&bar[XB_TMO], 1u); break; } }
    }
    nloc = mine > 0u ? mine : 1u; nx = cnt > 0u ? cnt : 1u;
}
__device__ __forceinline__ void xcd_barrier(const XcdBarrier& b) {
    asm volatile("s_waitcnt vmcnt(0)" ::: "memory");
    __syncthreads();
    if (threadIdx.x == 0) {
        unsigned* bar = b.bar;
        __builtin_amdgcn_s_waitcnt(0);
        unsigned nloc = b.st[0], nx = b.st[1];
        if (nloc == 0u) { xcd_barrier_complete(bar, b.x, nloc, nx); b.st[0] = nloc; b.st[1] = nx; }
        const unsigned old = xb_add(&bar[XB_XSUB(b.x)], 1u);
        const unsigned gen = old / nloc;
        if (old + 1u == (gen + 1u) * nloc) {
            __builtin_amdgcn_fence(__ATOMIC_RELEASE, "agent");
            asm volatile("s_waitcnt vmcnt(0)" ::: "memory");
            const unsigned og = xb_add(&bar[XB_TOP], 1u);
            const unsigned tg = og / nx;
            if (og + 1u == (tg + 1u) * nx) xb_add(&bar[XB_TOPGEN], 1u);
            else XB_SPIN(xb_ld(&bar[XB_TOPGEN]) == tg, bar);
            __builtin_amdgcn_fence(__ATOMIC_ACQUIRE, "agent");
            xb_add(&bar[XB_XGEN(b.x)], 1u);
            asm volatile("s_waitcnt vmcnt(0)" ::: "memory");
        } else {
            XB_SPIN(xb_ld(&bar[XB_XGEN(b.x)]) == gen, bar);
            __builtin_amdgcn_fence(__ATOMIC_ACQUIRE, "agent");
            asm volatile("s_waitcnt vmcnt(0)" ::: "memory");
        }
    }
    __syncthreads();
}

__device__ __forceinline__ float row_rstd(const float* ssp, int row, int fq) {
    const f32x4 v = *(const f32x4*)(ssp + (size_t)row * 16 + 4 * fq);
    float s = (v.x + v.y) + (v.z + v.w);
    s += __shfl_xor(s, 16); s += __shfl_xor(s, 32);
    return rsqrtf(s * (1.0f / D) + EPS);
}
__device__ __forceinline__ v4u pack8(const f32x4& a, const f32x4& b) {
    v4u w; w.x = pg8::cvt_pk_bf16(a[0], a[1]); w.y = pg8::cvt_pk_bf16(a[2], a[3]); w.z = pg8::cvt_pk_bf16(b[0], b[1]); w.w = pg8::cvt_pk_bf16(b[2], b[3]); return w;
}
__device__ __forceinline__ void unpack8(const v4u& w, f32x4& a, f32x4& b) {
    a = (f32x4){bflo(w.x), bfhi(w.x), bflo(w.y), bfhi(w.y)}; b = (f32x4){bflo(w.z), bfhi(w.z), bflo(w.w), bfhi(w.w)};
}
__device__ __forceinline__ f32x4 silu_mul4(const f32x4& g, const f32x4& u) {
    f32x4 o;
#pragma unroll
    for (int j = 0; j < 4; ++j) o[j] = g[j] * u[j] * sigmoidf_(g[j]);
    return o;
}
struct EpiSwiglu {
    static constexpr bool PERM = true, DUAL = false;
    bf16* H; const float* ssp;
    __device__ __forceinline__ void operator()(pg8::f32x4 (&acc)[2][2][4][2], const pg8::Unit& u, int wr, int wc, int fr, int fq) const {
        const int row0 = u.pm * 256 + wr * 64 + fr, col0 = u.pn * 128 + wc * 32 + 8 * fq;
#pragma unroll
        for (int ai = 0; ai < 2; ++ai)
#pragma unroll
            for (int m = 0; m < 4; ++m) {
                const int row = row0 + ai * 128 + m * 16; const float rs = row_rstd(ssp, row, fq);
                const f32x4 h0 = silu_mul4(acc[ai][0][m][0] * rs, acc[ai][1][m][0] * rs), h1 = silu_mul4(acc[ai][0][m][1] * rs, acc[ai][1][m][1] * rs);
                *(v4u*)(H + (size_t)row * FF + col0) = pack8(h0, h1);
            }
    }
};
template <bool WB, bool SS> struct EpiResid {
    static constexpr bool PERM = true, DUAL = false;
    const float* base; float* out; bf16* hb; float* ssp; float alpha;
    __device__ __forceinline__ void operator()(pg8::f32x4 (&acc)[2][2][4][2], const pg8::Unit& u, int wr, int wc, int fr, int fq) const {
        const int row0 = u.pm * 256 + wr * 64 + fr, col0 = u.pn * 256 + wc * 32 + 8 * fq;
#pragma unroll
        for (int ai = 0; ai < 2; ++ai)
#pragma unroll
            for (int m = 0; m < 4; ++m) {
                const int row = row0 + ai * 128 + m * 16; const size_t off = (size_t)row * D + col0; float ss = 0.f;
#pragma unroll
                for (int bj = 0; bj < 2; ++bj) {
                    const f32x4 r0 = *(const f32x4*)(base + off + bj * 128), r1 = *(const f32x4*)(base + off + bj * 128 + 4);
                    const f32x4 v0 = r0 + acc[ai][bj][m][0] * alpha, v1 = r1 + acc[ai][bj][m][1] * alpha;
                    *(f32x4*)(out + off + bj * 128) = v0; *(f32x4*)(out + off + bj * 128 + 4) = v1;
                    if (WB) *(v4u*)(hb + off + bj * 128) = pack8(v0, v1);
                    if (SS) ss += ((v0[0] * v0[0] + v0[1] * v0[1]) + (v0[2] * v0[2] + v0[3] * v0[3])) + ((v1[0] * v1[0] + v1[1] * v1[1]) + (v1[2] * v1[2] + v1[3] * v1[3]));
                }
                if (SS) { ss += __shfl_xor(ss, 16); ss += __shfl_xor(ss, 32); if (fq == 0) ssp[(size_t)row * 16 + u.pn * 4 + wc] = ss; }
                asm volatile("" ::: "memory");
            }
    }
};
struct EpiZin {
    static constexpr bool PERM = true, DUAL = false;
    bf16* Z; const float* ssp;
    __device__ __forceinline__ void operator()(pg8::f32x4 (&acc)[2][2][4][2], const pg8::Unit& u, int wr, int wc, int fr, int fq) const {
        const int row0 = u.pm * 256 + wr * 64 + fr; const int type = u.pn >> 3;
        const int cpair = (u.pn & 7) * 128 + wc * 32 + 8 * fq, cb = (u.pn - 24) * 256 + wc * 32 + 8 * fq;
#pragma unroll
        for (int ai = 0; ai < 2; ++ai)
#pragma unroll
            for (int m = 0; m < 4; ++m) {
                const int row = row0 + ai * 128 + m * 16; const float rs = row_rstd(ssp, row, fq);
                const f32x4 p0 = acc[ai][0][m][0] * rs, p1 = acc[ai][0][m][1] * rs, q0 = acc[ai][1][m][0] * rs, q1 = acc[ai][1][m][1] * rs;
                if (type == 0) {
                    f32x4 o0, o1;
#pragma unroll
                    for (int j = 0; j < 4; ++j) { o0[j] = p0[j] * sigmoidf_(q0[j]); o1[j] = p1[j] * sigmoidf_(q1[j]); }
                    *(v4u*)(Z + (size_t)row * D + cpair) = pack8(o0, o1);
                } else if (type == 1) {
                    *(v4u*)(Z + ZS + (size_t)row * D + cpair) = pack8(p0 * q0, p1 * q1);
                } else if (type == 2) {
                    f32x4 r0, r1, s0, s1;
#pragma unroll
                    for (int j = 0; j < 4; ++j) {
                        const float ea0 = fast_exp(-fminf(fmaxf(p0[j], -60.f), 60.f)), eb0 = fast_exp(-fminf(fmaxf(q0[j], -60.f), 60.f));
                        const float ea1 = fast_exp(-fminf(fmaxf(p1[j], -60.f), 60.f)), eb1 = fast_exp(-fminf(fmaxf(q1[j], -60.f), 60.f));
                        s0[j] = fast_rcp(1.f + eb0); s1[j] = fast_rcp(1.f + eb1);
                        r0[j] = (1.f + eb0) * fast_rcp(1.f + ea0); r1[j] = (1.f + eb1) * fast_rcp(1.f + ea1);
                    }
                    *(v4u*)(Z + 3 * ZS + (size_t)row * D + cpair) = pack8(r0, r1);
                    *(v4u*)(Z + 4 * ZS + (size_t)row * D + cpair) = pack8(s0, s1);
                } else {
                    *(v4u*)(Z + 2 * ZS + (size_t)row * D + cb) = pack8(p0, p1);
                    *(v4u*)(Z + 2 * ZS + (size_t)row * D + cb + 128) = pack8(q0, q1);
                }
            }
    }
};
struct EpiMix {
    static constexpr bool PERM = true, DUAL = true;
    const bf16* ratio; const bf16* sgb; bf16* O;
    __device__ __forceinline__ void mid(pg8::f32x4 (&acc)[2][2][4][2], const pg8::Unit& u, int wr, int wc, int fr, int fq) const {
        const int row0 = u.pm * 256 + wr * 64 + fr, col0 = u.pn * 256 + wc * 32 + 8 * fq;
#pragma unroll
        for (int ai = 0; ai < 2; ++ai)
#pragma unroll
            for (int m = 0; m < 4; ++m) {
                const size_t off = (size_t)(row0 + ai * 128 + m * 16) * D + col0;
#pragma unroll
                for (int bj = 0; bj < 2; ++bj) { const v4u w = *(const v4u*)(ratio + off + bj * 128); f32x4 a, b; unpack8(w, a, b); acc[ai][bj][m][0] *= a; acc[ai][bj][m][1] *= b; }
                if (m & 1) asm volatile("" ::: "memory");
            }
    }
    __device__ __forceinline__ void operator()(pg8::f32x4 (&acc)[2][2][4][2], const pg8::Unit& u, int wr, int wc, int fr, int fq) const {
        const int row0 = u.pm * 256 + wr * 64 + fr, col0 = u.pn * 256 + wc * 32 + 8 * fq;
#pragma unroll
        for (int ai = 0; ai < 2; ++ai)
#pragma unroll
            for (int m = 0; m < 4; ++m) {
                const size_t off = (size_t)(row0 + ai * 128 + m * 16) * D + col0;
#pragma unroll
                for (int bj = 0; bj < 2; ++bj) { const v4u w = *(const v4u*)(sgb + off + bj * 128); f32x4 a, b; unpack8(w, a, b);
                    *(v4u*)(O + off + bj * 128) = pack8(acc[ai][bj][m][0] * a, acc[ai][bj][m][1] * b); }
                if (m & 1) asm volatile("" ::: "memory");
            }
    }
};

__device__ __forceinline__ float wave_sum(float v) {
#pragma unroll
    for (int o = 1; o < 64; o <<= 1) v += __shfl_xor(v, o);
    return v;
}
__device__ __forceinline__ void p0_transpose_item(const float* W, const float* gain, int K, int N, bf16* WT, int k0, int n0, int drow, LAS float* scr, int lane) {
#pragma unroll 8
    for (int i = 0; i < 32; ++i) { const int kk = 2 * i + (lane >> 5); const float gk = gain ? gain[k0 + kk] : 1.0f; scr[kk * 33 + (lane & 31)] = W[(size_t)(k0 + kk) * N + n0 + (lane & 31)] * gk; }
    LDS_WAIT(); asm volatile("" ::: "memory");
    const int c = lane & 7;
#pragma unroll
    for (int j = 0; j < 4; ++j) { const int n = (lane >> 3) + 8 * j; const LAS float* s = scr + (8 * c) * 33 + n;
        v4u o; o.x = pk2(s[0 * 33], s[1 * 33]); o.y = pk2(s[2 * 33], s[3 * 33]); o.z = pk2(s[4 * 33], s[5 * 33]); o.w = pk2(s[6 * 33], s[7 * 33]);
        *(GAS v4u*)(WT + (size_t)(drow + n) * K + k0 + 8 * c) = o; }
    LDS_WAIT(); asm volatile("" ::: "memory");
}
__device__ __forceinline__ int dest_row(int mode, int n0) {
    if (mode == 0) return n0;
    if (mode == 1) return 256 * (n0 >> 7) + (n0 & 127);
    if (mode == 2) return 256 * (n0 >> 7) + 128 + (n0 & 127);
    const int s = n0 >> 10, j = n0 & 1023, pj = 256 * (j >> 7) + (j & 127);
    switch (s) {
        case 0: return pj;
        case 1: return pj + 128;
        case 2: return 6144 + j;
        case 3: return 2048 + pj;
        case 4: return 2048 + pj + 128;
        case 5: return 4096 + pj;
        default: return 4096 + pj + 128;
    }
}
__device__ __forceinline__ void p0_weight(const float* W, const float* gain, int K, int N, bf16* WT, int mode, int item, LAS float* scr, int lane) {
    const int nblk = N / 32, kb = item / nblk, nb = item % nblk;
    p0_transpose_item(W, gain, K, N, WT, 64 * kb, 32 * nb, dest_row(mode, 32 * nb), scr, lane);
}

struct Args { const float* in[20]; float* out; unsigned char* ws; int ph_lo, ph_hi, use_bar, pad; };

__global__ void __launch_bounds__(NWAVES * 64, 2) mk_fwd(Args args) {
    extern __shared__ __attribute__((aligned(16))) unsigned char lds_raw[];
    LAS unsigned char* lds = (LAS unsigned char*)lds_raw;
    volatile LAS unsigned* MISC = (volatile LAS unsigned*)(lds + MISC_OFF);
    const int tid = threadIdx.x, lane = tid & 63, wave = __builtin_amdgcn_readfirstlane(tid >> 6);
    const int G = gridDim.x; const int bx = blockIdx.x; const int vcu = (G % 8 == 0) ? (bx % 8) * (G / 8) + bx / 8 : bx;
    unsigned char* ws = args.ws;
    gu32* ctl = (gu32*)(ws + WS_CTL);
    const float* x = args.in[0];
    float* out = args.out;
    float* ssp1 = (float*)(ws + WS_SSP1); float* ssp2 = (float*)(ws + WS_SSP2); float* ssp3 = (float*)(ws + WS_SSP3);
    bf16* W1 = (bf16*)(ws + WS_W1); bf16* WD1 = (bf16*)(ws + WS_WD1); bf16* WIN = (bf16*)(ws + WS_WIN); bf16* WA = (bf16*)(ws + WS_WA); bf16* WB = (bf16*)(ws + WS_WB);
    bf16* WO = (bf16*)(ws + WS_WO); bf16* W2 = (bf16*)(ws + WS_W2); bf16* WD2 = (bf16*)(ws + WS_WD2);
    bf16* RA = (bf16*)(ws + WS_RA); bf16* Z = (bf16*)(ws + WS_Z); bf16* HID = (bf16*)(ws + WS_HID);

    for (int u = tid; u < (LDS_BYTES - LDSCTL_OFF) / 4; u += NWAVES * 64) ((LAS unsigned*)(lds + LDSCTL_OFF))[u] = 0u;
    __syncthreads();
    XcdBarrier bar; bar.bar = (unsigned*)(ctl + CW_BAR); bar.x = 0; bar.st = nullptr;
    if (args.use_bar) bar = xcd_barrier_post((unsigned*)(ctl + CW_BAR), MISC + 8);
    const int lo = args.ph_lo, hi = args.ph_hi;
#define IN(k) (lo <= (k) && (k) < hi)
#define SEAM(k) do { if (IN(k) && IN((k) + 1)) xcd_barrier(bar); } while (0)

    if (IN(0)) {
        LAS float* scr = (LAS float*)(lds + wave * 16384);
        const int gw = vcu * NWAVES + wave, NGW = G * NWAVES;
        constexpr int I_GU = (D / 64) * (FF / 32), I_DN = (FF / 64) * (D / 32), I_IN = (D / 64) * (DIN / 32), I_SQ = (D / 64) * (D / 32);
        constexpr int NITEMS = 4 * I_GU + 2 * I_DN + I_IN + 3 * I_SQ;
        for (int it = gw; it < NITEMS; it += NGW) {
            int r = it;
            if (r < I_GU) { p0_weight(args.in[2], args.in[1], D, FF, W1, 1, r, scr, lane); continue; } r -= I_GU;
            if (r < I_GU) { p0_weight(args.in[3], args.in[1], D, FF, W1, 2, r, scr, lane); continue; } r -= I_GU;
            if (r < I_DN) { p0_weight(args.in[4], nullptr, FF, D, WD1, 0, r, scr, lane); continue; } r -= I_DN;
            if (r < I_IN) { p0_weight(args.in[6], args.in[5], D, DIN, WIN, 3, r, scr, lane); continue; } r -= I_IN;
            if (r < I_SQ) { p0_weight(args.in[11], nullptr, D, D, WA, 0, r, scr, lane); continue; } r -= I_SQ;
            if (r < I_SQ) { p0_weight(args.in[13], nullptr, D, D, WB, 0, r, scr, lane); continue; } r -= I_SQ;
            if (r < I_SQ) { p0_weight(args.in[14], nullptr, D, D, WO, 0, r, scr, lane); continue; } r -= I_SQ;
            if (r < I_GU) { p0_weight(args.in[16], args.in[15], D, FF, W2, 1, r, scr, lane); continue; } r -= I_GU;
            if (r < I_GU) { p0_weight(args.in[17], args.in[15], D, FF, W2, 2, r, scr, lane); continue; } r -= I_GU;
            p0_weight(args.in[18], nullptr, FF, D, WD2, 0, r, scr, lane);
        }
        for (int m = gw; m < M; m += NGW) {
            const GAS f32x4* xr = (const GAS f32x4*)(x + (size_t)m * D) + lane; f32x4 v[4]; float s = 0.f;
#pragma unroll
            for (int j = 0; j < 4; ++j) { v[j] = xr[64 * j]; s += (v[j].x * v[j].x + v[j].y * v[j].y) + (v[j].z * v[j].z + v[j].w * v[j].w); }
            s = wave_sum(s);
            GAS v2u* o8 = (GAS v2u*)(RA + (size_t)m * D) + lane;
#pragma unroll
            for (int j = 0; j < 4; ++j) { v2u o; o.x = pk2(v[j].x, v[j].y); o.y = pk2(v[j].z, v[j].w); o8[64 * j] = o; }
            if (lane < 16) ssp1[(size_t)m * 16 + lane] = (lane == 0) ? s : 0.f;
        }
    }
    SEAM(0);
    if (IN(1)) {
        pg8::Gemm g{RA, W1, nullptr, nullptr, M, 2 * FF, D}; pg8::StaticOrder S; S.init(M, 2 * FF, G, bx);
        EpiSwiglu E{HID, ssp1};
        pg8::gemm_phase<EpiSwiglu, pg8::StaticOrder, PG8_ALIGN, PG8_SP2>(lds, g, S, E);
    }
    SEAM(1);
    if (IN(2)) {
        pg8::Gemm g{HID, WD1, nullptr, nullptr, M, D, FF}; pg8::StaticOrder S; S.init(M, D, G, bx);
        EpiResid<true, true> E{x, out, RA, ssp2, 0.5f};
        pg8::gemm_phase<EpiResid<true, true>, pg8::StaticOrder, PG8_ALIGN, PG8_SP2>(lds, g, S, E);
    }
    SEAM(2);
    if (IN(3)) {
        pg8::Gemm g{RA, WIN, nullptr, nullptr, M, DIN, D}; pg8::StaticOrder S; S.init(M, DIN, G, bx);
        EpiZin E{Z, ssp2};
        pg8::gemm_phase<EpiZin, pg8::StaticOrder, PG8_ALIGN, PG8_SP2>(lds, g, S, E);
    }
    SEAM(3);
    if (IN(4)) {
        const int c0 = 2 * tid;
        f32x2 wA[CA];
#pragma unroll
        for (int k = 0; k < CA; ++k) wA[k] = *(const f32x2*)(args.in[7] + (size_t)k * D + c0);
        const f32x2 cbias = *(const f32x2*)(args.in[8] + c0), lng = *(const f32x2*)(args.in[9] + c0), lnb = *(const f32x2*)(args.in[10] + c0);
        const f32x2 wB0 = *(const f32x2*)(args.in[12] + c0), wB1 = *(const f32x2*)(args.in[12] + D + c0), wB2 = *(const f32x2*)(args.in[12] + 2 * D + c0);
        const bf16* Z0 = Z; const bf16* Z1 = Z + ZS; bf16* Z2 = Z + 2 * ZS;
        LAS unsigned* tile32 = (LAS unsigned*)lds;
        LAS f32x2* P = (LAS f32x2*)(lds + 62 * 2048);
        LAS f32x2* Sx = (LAS f32x2*)(lds + 62 * 2048 + 1024);
        for (int tile = vcu; tile < M / 32; tile += G) {
            const int t0g = tile * 32, tin = t0g & (SEQ - 1);
            for (int i = tid; i < 62 * 128; i += NWAVES * 64) { const int j = i >> 7, ch = i & 127;
                v4u v = (v4u){0u, 0u, 0u, 0u}; if (tin - 30 + j >= 0) v = *(const GAS v4u*)(Z0 + (size_t)(t0g - 30 + j) * D + ch * 8);
                *(LAS v4u*)(lds + j * 2048 + ch * 16) = v; }
            __syncthreads();
            for (int grp = 0; grp < 2; ++grp) {
                f32x2 a[16];
#pragma unroll
                for (int tt = 0; tt < 16; ++tt) a[tt] = cbias;
#pragma unroll
                for (int r = 0; r < 46; ++r) {
                    const unsigned xv = tile32[(grp * 16 + r) * 512 + tid]; const f32x2 xf = (f32x2){bflo(xv), bfhi(xv)};
#pragma unroll
                    for (int tt = 0; tt < 16; ++tt) { const int k = r - tt; if (k >= 0 && k < CA) a[tt] = xf * wA[k] + a[tt]; }
                }
                float v[32];
#pragma unroll
                for (int tt = 0; tt < 16; ++tt) { v[2 * tt] = a[tt].x + a[tt].y; v[2 * tt + 1] = a[tt].x * a[tt].x + a[tt].y * a[tt].y; }
#pragma unroll
                for (int st = 0; st < 5; ++st) {
                    const int o = 1 << st, n = 16 >> st; const bool up = (lane & o) != 0;
#pragma unroll
                    for (int i = 0; i < n; ++i) { const float lo_ = v[i], hi_ = v[i + n]; const float send = up ? lo_ : hi_, keep = up ? hi_ : lo_; v[i] = keep + __shfl_xor(send, o); }
                }
                v[0] += __shfl_xor(v[0], 32);
                {
                    const int idx = ((lane & 1) << 4) | ((lane & 2) << 2) | (lane & 4) | ((lane & 8) >> 2) | ((lane & 16) >> 4);
                    if (lane < 32) ((LAS float*)P)[wave * 32 + idx] = v[0];
                }
                __syncthreads();
                if (tid < 16) { float s = 0.f, q = 0.f;
#pragma unroll
                    for (int w = 0; w < 8; ++w) { const f32x2 p = P[w * 16 + tid]; s += p.x; q += p.y; }
                    const float mean = s * (1.0f / D), var = q * (1.0f / D) - mean * mean; Sx[tid] = (f32x2){mean, rsqrtf(var + EPS)}; }
                __syncthreads();
#pragma unroll
                for (int tt = 0; tt < 16; ++tt) {
                    const f32x2 st = Sx[tt]; const f32x2 y = (a[tt] - st.x) * st.y * lng + lnb;
                    const float o0 = y.x * sigmoidf_(y.x), o1 = y.y * sigmoidf_(y.y);
                    *(GAS unsigned*)(RA + (size_t)(t0g + grp * 16 + tt) * D + c0) = pg8::cvt_pk_bf16(o0, o1);
                }
            }
            {
                f32x2 xm2 = (f32x2){0.f, 0.f}, xm1 = (f32x2){0.f, 0.f};
                if (tin > 0) { const unsigned u2 = *(const GAS unsigned*)(Z1 + (size_t)(t0g - 2) * D + c0), u1 = *(const GAS unsigned*)(Z1 + (size_t)(t0g - 1) * D + c0);
                    xm2 = (f32x2){bflo(u2), bfhi(u2)}; xm1 = (f32x2){bflo(u1), bfhi(u1)}; }
#pragma unroll 8
                for (int tt = 0; tt < 32; ++tt) {
                    const size_t off = (size_t)(t0g + tt) * D + c0;
                    const unsigned ux = *(const GAS unsigned*)(Z1 + off), ub = *(const GAS unsigned*)(Z2 + off);
                    const f32x2 x0 = (f32x2){bflo(ux), bfhi(ux)}, bb = (f32x2){bflo(ub), bfhi(ub)};
                    const f32x2 vv = (wB0 * xm2 + wB1 * xm1 + wB2 * x0) * bb;
                    *(GAS unsigned*)(Z2 + off) = pg8::cvt_pk_bf16(vv.x, vv.y);
                    xm2 = xm1; xm1 = x0;
                }
            }
            __syncthreads();
        }
    }
    SEAM(4);
    if (IN(5)) {
        pg8::Gemm g{RA, WA, Z + 2 * ZS, WB, M, D, D}; pg8::DualOrder S; S.s.init(M, D, G, bx);
        EpiMix E{Z + 3 * ZS, Z + 4 * ZS, Z};
        pg8::gemm_phase<EpiMix, pg8::DualOrder, PG8_ALIGN, PG8_SP2>(lds, g, S, E);
    }
    SEAM(5);
    if (IN(6)) {
        pg8::Gemm g{Z, WO, nullptr, nullptr, M, D, D}; pg8::StaticOrder S; S.init(M, D, G, bx);
        EpiResid<true, true> E{out, out, RA, ssp3, 1.0f};
        pg8::gemm_phase<EpiResid<true, true>, pg8::StaticOrder, PG8_ALIGN, PG8_SP2>(lds, g, S, E);
    }
    SEAM(6);
    if (IN(7)) {
        pg8::Gemm g{RA, W2, nullptr, nullptr, M, 2 * FF, D}; pg8::StaticOrder S; S.init(M, 2 * FF, G, bx);
        EpiSwiglu E{HID, ssp3};
        pg8::gemm_phase<EpiSwiglu, pg8::StaticOrder, PG8_ALIGN, PG8_SP2>(lds, g, S, E);
    }
    SEAM(7);
    if (IN(8)) {
        pg8::Gemm g{HID, WD2, nullptr, nullptr, M, D, FF}; pg8::StaticOrder S; S.init(M, D, G, bx);
        EpiResid<false, false> E{out, out, nullptr, nullptr, 0.5f};
        pg8::gemm_phase<EpiResid<false, false>, pg8::StaticOrder, PG8_ALIGN, PG8_SP2>(lds, g, S, E);
    }
    SEAM(8);
    if (IN(9)) {
        const int gw = vcu * NWAVES + wave, NGW = G * NWAVES;
        const GAS f32x4* gf = (const GAS f32x4*)args.in[19] + lane;
        f32x4 gv[4];
#pragma unroll
        for (int j = 0; j < 4; ++j) gv[j] = gf[64 * j];
        for (int m = gw; m < M; m += NGW) {
            GAS f32x4* row = (GAS f32x4*)(out + (size_t)m * D) + lane; f32x4 v[4]; float s = 0.f;
#pragma unroll
            for (int j = 0; j < 4; ++j) { v[j] = row[64 * j]; s += (v[j].x * v[j].x + v[j].y * v[j].y) + (v[j].z * v[j].z + v[j].w * v[j].w); }
            const float rstd = rsqrtf(wave_sum(s) * (1.0f / D) + EPS);
#pragma unroll
            for (int j = 0; j < 4; ++j) row[64 * j] = v[j] * rstd * gv[j];
        }
    }
#undef IN
#undef SEAM
}

extern "C" void kernel_launch(void* const* d_in, const int* in_sizes, int n_in, void* d_out, int out_size, void* d_ws, size_t ws_size, hipStream_t stream) {
    static int grid = 0;
    if (grid == 0) {
        if (n_in != 20 || in_sizes[0] != M * D || out_size != M * D || ws_size < WS_END) {
            fprintf(stderr, "kernel_launch: built for 20 inputs, x/out of %d floats, >= %zu bytes of workspace; got n_in %d, in0 %d, out %d, ws %zu; nothing launched\n", M * D, (size_t)WS_END, n_in, n_in > 0 ? in_sizes[0] : -1, out_size, ws_size);
            grid = -1; return; }
        int dev = 0, cus = 0, per_cu = 0;
        if (hipGetDevice(&dev) != hipSuccess || hipDeviceGetAttribute(&cus, hipDeviceAttributeMultiprocessorCount, dev) != hipSuccess) { fprintf(stderr, "kernel_launch: device query failed\n"); grid = -1; return; }
        if (hipFuncSetAttribute((const void*)mk_fwd, hipFuncAttributeMaxDynamicSharedMemorySize, LDS_BYTES) != hipSuccess) { fprintf(stderr, "kernel_launch: hipFuncSetAttribute failed\n"); grid = -1; return; }
        if (hipOccupancyMaxActiveBlocksPerMultiprocessor(&per_cu, (const void*)mk_fwd, NWAVES * 64, LDS_BYTES) != hipSuccess || per_cu < 1) { fprintf(stderr, "kernel_launch: occupancy query says %d blocks per CU\n", per_cu); per_cu = 1; }
        (void)hipGetLastError();
        grid = cus;
        if (grid % 8 != 0 || (M / 256) * 4 % grid != 0) fprintf(stderr, "kernel_launch: note: grid %d does not divide the tile counts evenly\n", grid);
    }
    if (grid < 0) return;
    if (hipMemsetAsync((char*)d_ws + WS_CTL, 0, CTL_ZERO_BYTES, stream) != hipSuccess) { fprintf(stderr, "kernel_launch: memset failed\n"); return; }
    Args a{};
    for (int i = 0; i < 20; ++i) a.in[i] = (const float*)d_in[i];
    a.out = (float*)d_out; a.ws = (unsigned char*)d_ws;
    if (MK_N_LAUNCHES == 1) {
        a.ph_lo = 0; a.ph_hi = N_PHASES; a.use_bar = 1;
        hipLaunchKernelGGL(mk_fwd, dim3(grid), dim3(NWAVES * 64), LDS_BYTES, stream, a);
    } else {
        for (int p = 0; p < N_PHASES; ++p) { a.ph_lo = p; a.ph_hi = p + 1; a.use_bar = 0;
            hipLaunchKernelGGL(mk_fwd, dim3(grid), dim3(NWAVES * 64), LDS_BYTES, stream, a); }
    }
    const hipError_t le = hipPeekAtLastError();
    if (le != hipSuccess) fprintf(stderr, "kernel_launch: launch failed: %s\n", hipGetErrorName(le));
}
```

```cpp
#include <hip/hip_runtime.h>
#include <cstdio>
#include <cstdint>
#include <type_traits>

#ifndef MK_N_LAUNCHES
#define MK_N_LAUNCHES 1
#endif
#define MK_KREP 1
#define MK_Q2 1
#define MK_REP_PHASE -1
#define MK_PROBE_A 3
#define MK_PROBE_B 0

namespace pg8 {
#define PG8_LAS __attribute__((address_space(3)))
typedef unsigned short bf16_t;
typedef short bf16x8 __attribute__((ext_vector_type(8)));
typedef float f32x4 __attribute__((ext_vector_type(4)));
typedef unsigned u32x4 __attribute__((ext_vector_type(4)));
typedef int i32x4 __attribute__((ext_vector_type(4)));
__device__ __forceinline__ f32x4 mma16(const bf16x8& b, const bf16x8& a, const f32x4& c) { return __builtin_amdgcn_mfma_f32_16x16x32_bf16(b, a, c, 0, 0, 0); }
__device__ __forceinline__ i32x4 mma16(const bf16x8& b, const bf16x8& a, const i32x4& c) { return __builtin_amdgcn_mfma_i32_16x16x64_i8(__builtin_bit_cast(i32x4, b), __builtin_bit_cast(i32x4, a), c, 0, 0, 0); }
constexpr int BM = 256, BK = 64, HALF = 128, HTB = HALF * BK * 2  , STAGE_BYTES = 8 * HTB, NXCD = 8, WGM = 8;

__host__ __device__ __forceinline__ int lds_byte(int r, int c) { const int st = (r >> 4) * 2 + (c >> 5), rr = r & 15, cc = c & 31, ob = rr * 64 + cc * 2; return st * 1024 + (ob ^ (((ob >> 9) & 1) << 5)); }
__host__ __device__ __forceinline__ void stage_rc(int b, int& R, int& C) { const int st = b / 1024, sb = b % 1024, swz = sb ^ (((sb >> 9) & 1) << 5); R = (st >> 1) * 16 + swz / 64; C = (st & 1) * 32 + (swz % 64) / 2; }
__host__ __device__ __forceinline__ int perm32(int rho) { const int n = rho >> 4, i = rho & 15; return 8 * (i >> 2) + 4 * n + (i & 3); }

struct Unit { int pm, pn, sel; };
struct Gemm { const bf16_t* A; const bf16_t* Bt; const bf16_t* A2; const bf16_t* Bt2; int M, N, K; size_t laneA, laneA2; };

template <int NM, int NN> struct StaticOrderT {
    static_assert(NM % WGM == 0 && (NM * NN) % NXCD == 0, "tile counts");
    static constexpr int nwg = NM * NN, q = nwg / NXCD, nig = WGM * NN;
    int G, c;
    __device__ __forceinline__ void init(int G_, int c_) { G = G_; c = c_; }
    __device__ __forceinline__ bool next(int i, Unit& u) const {
        const int L = i * G + c; if (L >= nwg) return false;
        const int wgid = (L & (NXCD - 1)) * q + (L >> 3);
        const int gid = wgid / nig, rem = wgid - gid * nig;
        u.pm = gid * WGM + (rem & (WGM - 1)); u.pn = rem >> 3; u.sel = 0; return true;
    }
};
template <int NM, int NN, int MODE> struct MapOrderT {
    StaticOrderT<NM, NN> s;
    __device__ __forceinline__ void init(int G_, int c_) { s.init(G_, c_); }
    __device__ __forceinline__ bool next(int i, Unit& u) const { if (!s.next(i, u)) return false; u.pn = MODE == 0 ? (u.pn < 8 ? u.pn : u.pn + 8) : (u.pn < 8 ? u.pn + 8 : u.pn + 16); return true; }
};
template <int NM, int NN> struct DualOrderT {
    StaticOrderT<NM, NN> s;
    __device__ bool next(int j, Unit& u) const { if (!s.next(j >> 1, u)) return false; u.sel = j & 1; return true; }
};

__device__ __forceinline__ unsigned cvt_pk_bf16(float lo, float hi) { unsigned r; asm volatile("v_cvt_pk_bf16_f32 %0, %1, %2" : "=v"(r) : "v"(lo), "v"(hi)); return r; }

template <class E, class = void> struct mixed_of { static constexpr bool value = false; };
template <class E> struct mixed_of<E, typename std::enable_if<E::MIXED>::type> { static constexpr bool value = true; };
template <class E, class = void> struct pre_of { static constexpr bool value = false; };
template <class E> struct pre_of<E, typename std::enable_if<E::PRE>::type> { static constexpr bool value = true; };
template <class Epi, class Sched, bool ALIGN_EPI = false, bool SP2 = false>
__device__ __forceinline__ void gemm_phase(PG8_LAS unsigned char* lds, const Gemm g, const Sched& S, const Epi& E) {
    const int tid = threadIdx.x, wid = __builtin_amdgcn_readfirstlane(tid >> 6), lane = tid & 63, wr = wid >> 2, wc = wid & 3, fr = lane & 15, fq = lane >> 4;
    const int K = g.K, nt = K / BK;
    unsigned voffA[2], voffB[2];
#pragma unroll
    for (int i = 0; i < 2; ++i) { int R, C; stage_rc(tid * 16 + i * 8192, R, C); const int Rb = Epi::PERM ? ((R & ~31) + perm32(R & 31)) : R;
        voffA[i] = (unsigned)(R * K + C) * 2u; voffB[i] = (unsigned)(Rb * K + C) * 2u; }
    const size_t kstep = (size_t)(BK * 2);
    const size_t hstep = (size_t)HALF * K * 2;
    const size_t tstep = 2 * hstep;
    const unsigned ldsw = (unsigned)wid * 1024u;
    const int aoff = lds_byte(wr * 64 + fr, fq * 8), boff = lds_byte(wc * 32 + fr, fq * 8);
#define PG8_SA(b, h) (((b) * 2 + (h)) * HTB)
#define PG8_SB(b, h) ((4 + (b) * 2 + (h)) * HTB)
#define PG8_STAGE(bufoff, gbase, voff) do { const __amdgpu_buffer_rsrc_t r_ = __builtin_amdgcn_make_buffer_rsrc((void*)(gbase), 0, 0x7fffffff, 0x00020000); \
        _Pragma("unroll") for (int _i = 0; _i < 2; ++_i) \
        __builtin_amdgcn_raw_ptr_buffer_load_lds(r_, (PG8_LAS void*)(lds + (bufoff) + ldsw + _i * 8192), 16, (int)(voff)[_i], 0, 0, 0); } while (0)
#define PG8_LDA(dst, b, h) do { _Pragma("unroll") for (int m = 0; m < 4; ++m) _Pragma("unroll") for (int k = 0; k < 2; ++k) dst[m][k] = *(const PG8_LAS bf16x8*)(lds + PG8_SA(b, h) + aoff + m * 2048 + k * 1024); } while (0)
#define PG8_LDB(dst, b, h) do { _Pragma("unroll") for (int n = 0; n < 2; ++n) _Pragma("unroll") for (int k = 0; k < 2; ++k) dst[n][k] = *(const PG8_LAS bf16x8*)(lds + PG8_SB(b, h) + boff + n * 2048 + k * 1024); } while (0)
#define PG8_MMA(ai, bj, At, Bt) do { __builtin_amdgcn_s_setprio(1); _Pragma("unroll") for (int m = 0; m < 4; ++m) _Pragma("unroll") for (int n = 0; n < 2; ++n) _Pragma("unroll") for (int k = 0; k < 2; ++k) \
        acc[ai][bj][m][n] = mma16(Bt[n][k], At[m][k], acc[ai][bj][m][n]); __builtin_amdgcn_s_setprio(0); } while (0)
#define PG8_MMA_I8(ai, bj, At, Bt) do { __builtin_amdgcn_s_setprio(1); _Pragma("unroll") for (int m = 0; m < 4; ++m) _Pragma("unroll") for (int n = 0; n < 2; ++n) _Pragma("unroll") for (int k = 0; k < 2; ++k) \
        acc[ai][bj][m][n] = __builtin_bit_cast(acc_t, __builtin_amdgcn_mfma_i32_16x16x64_i8(__builtin_bit_cast(i32x4, Bt[n][k]), __builtin_bit_cast(i32x4, At[m][k]), __builtin_bit_cast(i32x4, acc[ai][bj][m][n]), 0, 0, 0)); \
        __builtin_amdgcn_s_setprio(0); } while (0)
#define PG8_ADDR(ntu) const bool last = (t == (ntu) - 2); const char* a1 = cA + (size_t)(t + 1) * kstep; \
        const char* a2 = last ? nA : cA + (size_t)(t + 2) * kstep; const char* b2 = last ? nB : cB + (size_t)(t + 2) * kstep; const char* a3 = a2 + kstep; const char* b3 = b2 + kstep
#define PG8_ITER(MMAM) do { \
        PG8_LDB(B0, 0, 0); PG8_LDB(B1, 0, 1); PG8_SCHED; PG8_LDA(At, 0, 0); PG8_STAGE(PG8_SA(1, 1), a1 + hstep, voffA); \
        PG8_WAIT_V(8); PG8_WAIT_L(0); PG8_BAR; MMAM(0, 0, At, B0); MMAM(0, 1, At, B1); PG8_BAR; PG8_SCHED; \
        PG8_LDA(At, 0, 1); PG8_STAGE(PG8_SB(0, 0), b2, voffB); PG8_STAGE(PG8_SB(0, 1), b2 + hstep, voffB); PG8_STAGE(PG8_SA(0, 0), a2, voffA); \
        PG8_WAIT_V(8); PG8_WAIT_L(0); PG8_BAR; MMAM(1, 0, At, B0); MMAM(1, 1, At, B1); PG8_BAR; PG8_SCHED; \
        PG8_LDB(B0, 1, 0); PG8_LDB(B1, 1, 1); PG8_SCHED; PG8_LDA(At, 1, 0); PG8_STAGE(PG8_SA(0, 1), a2 + hstep, voffA); \
        PG8_WAIT_V(8); PG8_WAIT_L(0); PG8_BAR; MMAM(0, 0, At, B0); MMAM(0, 1, At, B1); PG8_BAR; PG8_SCHED; \
        PG8_LDA(At, 1, 1); PG8_STAGE(PG8_SB(1, 0), b3, voffB); PG8_STAGE(PG8_SB(1, 1), b3 + hstep, voffB); PG8_STAGE(PG8_SA(1, 0), a3, voffA); \
        PG8_WAIT_V(8); PG8_WAIT_L(0); PG8_BAR; MMAM(1, 0, At, B0); MMAM(1, 1, At, B1); PG8_BAR; PG8_SCHED; } while (0)
#define PG8_ITERR(MMAM, vo2, hs2, vb2, hb2) do { \
        PG8_LDB(B0, 0, 0); PG8_LDB(B1, 0, 1); PG8_SCHED; PG8_LDA(At, 0, 0); PG8_STAGE(PG8_SA(1, 1), a1 + hstep, voffA); \
        PG8_WAIT_V(8); PG8_WAIT_L(0); PG8_BAR; MMAM(0, 0, At, B0); MMAM(0, 1, At, B1); PG8_BAR; PG8_SCHED; \
        PG8_LDA(At, 0, 1); PG8_STAGE(PG8_SB(0, 0), b2, vb2); PG8_STAGE(PG8_SB(0, 1), b2 + (hb2), vb2); PG8_STAGE(PG8_SA(0, 0), a2, vo2); \
        PG8_WAIT_V(8); PG8_WAIT_L(0); PG8_BAR; MMAM(1, 0, At, B0); MMAM(1, 1, At, B1); PG8_BAR; PG8_SCHED; \
        PG8_LDB(B0, 1, 0); PG8_LDB(B1, 1, 1); PG8_SCHED; PG8_LDA(At, 1, 0); PG8_STAGE(PG8_SA(0, 1), a2 + (hs2), vo2); \
        PG8_WAIT_V(8); PG8_WAIT_L(0); PG8_BAR; MMAM(0, 0, At, B0); MMAM(0, 1, At, B1); PG8_BAR; PG8_SCHED; \
        PG8_LDA(At, 1, 1); PG8_STAGE(PG8_SB(1, 0), b3, vb2); PG8_STAGE(PG8_SB(1, 1), b3 + (hb2), vb2); PG8_STAGE(PG8_SA(1, 0), a3, vo2); \
        PG8_WAIT_V(8); PG8_WAIT_L(0); PG8_BAR; MMAM(1, 0, At, B0); MMAM(1, 1, At, B1); PG8_BAR; PG8_SCHED; } while (0)
#define PG8_RDP(dst, slot) do { _Pragma("unroll") for (int m = 0; m < 4; ++m) dst[m] = *(const PG8_LAS u32x4*)(lds + (slot) + poff + m * 2048); } while (0)
#define PG8_ADDP(ai, J, src) do { if ((wc >> 1) == ((J) & 1)) { _Pragma("unroll") for (int m = 0; m < 4; ++m) { const u32x4 w_ = src[m]; \
        const f32x4 lo_ = (f32x4){__builtin_bit_cast(float, w_.x << 16), __builtin_bit_cast(float, w_.x & 0xffff0000u), __builtin_bit_cast(float, w_.y << 16), __builtin_bit_cast(float, w_.y & 0xffff0000u)}; \
        const f32x4 hi_ = (f32x4){__builtin_bit_cast(float, w_.z << 16), __builtin_bit_cast(float, w_.z & 0xffff0000u), __builtin_bit_cast(float, w_.w << 16), __builtin_bit_cast(float, w_.w & 0xffff0000u)}; \
        acc[ai][(J) >> 1][m][0] += lo_ * binv; acc[ai][(J) >> 1][m][1] += hi_ * binv; } } } while (0)
#define PG8_ITERP() do { \
        PG8_RDP(PA, PG8_SA(0, 0)); PG8_RDP(PB0, PG8_SB(0, 0)); PG8_RDP(PB1, PG8_SB(0, 1)); PG8_STAGE(PG8_SA(1, 1), pA + kstep + hstepP, voffP); \
        PG8_WAIT_V(8); PG8_WAIT_L(0); PG8_BAR; PG8_ADDP(0, 0, PA); PG8_ADDP(0, 2, PB0); PG8_ADDP(1, 2, PB1); PG8_BAR; PG8_SCHED; \
        PG8_RDP(PA, PG8_SA(0, 1)); PG8_STAGE(PG8_SB(0, 0), nB, voffB); PG8_STAGE(PG8_SB(0, 1), nB + hstep, voffB); PG8_STAGE(PG8_SA(0, 0), nA, voffA); \
        PG8_WAIT_V(8); PG8_WAIT_L(0); PG8_BAR; PG8_ADDP(1, 0, PA); PG8_BAR; PG8_SCHED; \
        PG8_RDP(PA, PG8_SA(1, 0)); PG8_RDP(PB0, PG8_SB(1, 0)); PG8_RDP(PB1, PG8_SB(1, 1)); PG8_STAGE(PG8_SA(0, 1), nA + hstep, voffA); \
        PG8_WAIT_V(8); PG8_WAIT_L(0); PG8_BAR; PG8_ADDP(0, 1, PA); PG8_ADDP(0, 3, PB0); PG8_ADDP(1, 3, PB1); PG8_BAR; PG8_SCHED; \
        PG8_RDP(PA, PG8_SA(1, 1)); PG8_STAGE(PG8_SB(1, 0), nB + kstep, voffB); PG8_STAGE(PG8_SB(1, 1), nB + kstep + hstep, voffB); PG8_STAGE(PG8_SA(1, 0), nA + kstep, voffA); \
        PG8_WAIT_V(8); PG8_WAIT_L(0); PG8_BAR; PG8_ADDP(1, 1, PA); PG8_BAR; PG8_SCHED; } while (0)
#define PG8_RAF(ai, BJ, slot) do { f32x4 f_[4][2]; _Pragma("unroll") for (int m = 0; m < 4; ++m) { f_[m][0] = *(const PG8_LAS f32x4*)(lds + (slot) + pofa + m * 2048); f_[m][1] = *(const PG8_LAS f32x4*)(lds + (slot) + pofb + m * 2048); } \
        PG8_WAIT_L(0); _Pragma("unroll") for (int m = 0; m < 4; ++m) { acc[ai][BJ][m][0] += f_[m][0] * binv; acc[ai][BJ][m][1] += f_[m][1] * binv; } } while (0)
#define PG8_ITERPF(BJ, LATE, A2, A3, B2, B3, VOA, HSA, VOB, HSB) do { \
        if (wc == 0) PG8_RAF(0, BJ, PG8_SA(0, 0)); if (wc == 2) { PG8_RAF(0, BJ, PG8_SB(0, 0)); PG8_RAF(1, BJ, PG8_SB(0, 1)); } PG8_STAGE(PG8_SA(1, 1), (LATE) + hstepF, voffF); \
        PG8_WAIT_V(8); PG8_WAIT_L(0); PG8_BAR; PG8_BAR; PG8_SCHED; \
        if (wc == 0) PG8_RAF(1, BJ, PG8_SA(0, 1)); PG8_STAGE(PG8_SB(0, 0), B2, VOB); PG8_STAGE(PG8_SB(0, 1), (B2) + (HSB), VOB); PG8_STAGE(PG8_SA(0, 0), A2, VOA); \
        PG8_WAIT_V(8); PG8_WAIT_L(0); PG8_BAR; PG8_BAR; PG8_SCHED; \
        if (wc == 1) PG8_RAF(0, BJ, PG8_SA(1, 0)); if (wc == 3) { PG8_RAF(0, BJ, PG8_SB(1, 0)); PG8_RAF(1, BJ, PG8_SB(1, 1)); } PG8_STAGE(PG8_SA(0, 1), (A2) + (HSA), VOA); \
        PG8_WAIT_V(8); PG8_WAIT_L(0); PG8_BAR; PG8_BAR; PG8_SCHED; \
        if (wc == 1) PG8_RAF(1, BJ, PG8_SA(1, 1)); PG8_STAGE(PG8_SB(1, 0), B3, VOB); PG8_STAGE(PG8_SB(1, 1), (B3) + (HSB), VOB); PG8_STAGE(PG8_SA(1, 0), A3, VOA); \
        PG8_WAIT_V(8); PG8_WAIT_L(0); PG8_BAR; PG8_BAR; PG8_SCHED; } while (0)
#define PG8_WAIT_V(n) asm volatile("s_waitcnt vmcnt(" #n ")" ::: "memory")
#define PG8_WAIT_L(n) asm volatile("s_waitcnt lgkmcnt(" #n ")" ::: "memory")
#define PG8_BAR __builtin_amdgcn_s_barrier()
#define PG8_SCHED __builtin_amdgcn_sched_barrier(0)
#define PG8_ZERO(ai) do { _Pragma("unroll") for (int b_ = 0; b_ < 2; ++b_) _Pragma("unroll") for (int m_ = 0; m_ < 4; ++m_) _Pragma("unroll") for (int n_ = 0; n_ < 2; ++n_) acc[ai][b_][m_][n_] = acc_t{}; } while (0)
#define PG8_ABASE(u) ((const char*)((u).sel ? g.A2 : g.A) + (size_t)(u).pm * tstep + (size_t)((u).pm >> 4) * ((u).sel ? g.laneA2 : g.laneA))
#define PG8_BBASE(u) ((const char*)((u).sel ? g.Bt2 : g.Bt) + (size_t)(u).pn * tstep)
    Unit cur, nxt; int ui = 0;
    if (!S.next(0, cur)) return;
#ifdef MK_PROBE
    PG8_LAS unsigned long long* pk = (PG8_LAS unsigned long long*)(lds + 131072 + 64);
#endif
    typedef typename Epi::acc_t acc_t;
    acc_t acc[2][2][4][2];
#pragma unroll
    for (int a = 0; a < 2; ++a)
#pragma unroll
        for (int b = 0; b < 2; ++b)
#pragma unroll
            for (int m = 0; m < 4; ++m)
#pragma unroll
                for (int n = 0; n < 2; ++n) acc[a][b][m][n] = acc_t{};
    bf16x8 At[4][2], B0[2][2], B1[2][2];
    const char* cA = PG8_ABASE(cur); const char* cB = PG8_BBASE(cur);
    bool pending = false; Unit prev = cur;
    if constexpr (SP2) {
        PG8_STAGE(PG8_SB(0, 0), cB, voffB); PG8_STAGE(PG8_SB(0, 1), cB + hstep, voffB); PG8_SCHED; PG8_STAGE(PG8_SA(0, 0), cA, voffA); PG8_STAGE(PG8_SA(0, 1), cA + hstep, voffA); PG8_SCHED;
        if constexpr (Epi::STASH) E.init(S, wr, fr, fq);
        if (wr == 1) PG8_BAR;
        PG8_WAIT_V(2); PG8_BAR;
        PG8_STAGE(PG8_SB(1, 0), cB + kstep, voffB); PG8_STAGE(PG8_SA(1, 0), cA + kstep, voffA); PG8_STAGE(PG8_SB(1, 1), cB + hstep + kstep, voffB);
        PG8_WAIT_V(6); PG8_BAR;
    } else {
        PG8_STAGE(PG8_SB(0, 0), cB, voffB); PG8_STAGE(PG8_SA(0, 0), cA, voffA); PG8_STAGE(PG8_SB(0, 1), cB + hstep, voffB); PG8_STAGE(PG8_SA(0, 1), cA + hstep, voffA);
        if constexpr (Epi::STASH) E.init(S, wr, fr, fq);
        if (wr == 1) PG8_BAR;
        PG8_WAIT_V(4); PG8_BAR;
        PG8_STAGE(PG8_SB(1, 0), cB + kstep, voffB); PG8_STAGE(PG8_SA(1, 0), cA + kstep, voffA); PG8_STAGE(PG8_SB(1, 1), cB + hstep + kstep, voffB);
        PG8_WAIT_V(6); PG8_BAR;
    }
    if constexpr (mixed_of<Epi>::value) {
        static_assert(!mixed_of<Epi>::value || (SP2 && ALIGN_EPI && Epi::DUAL && !Epi::SPLIT), "mixed dual GEMM: aligned SP2 loop");
        for (;;) {
            {   S.next(ui + 1, nxt);
                const char* nA = PG8_ABASE(nxt); const char* nB = PG8_BBASE(nxt);
                for (int t = 0; t < nt / 2; t += 2) { PG8_ADDR(nt / 2); PG8_ITER(PG8_MMA_I8); }
                if (wr == 0) PG8_BAR;
                E.mid(acc, cur, wr, wc, fr, fq);
                cur = nxt; cA = nA; cB = nB; ++ui;
                if (wr == 1) PG8_BAR; }
            {   const bool has_next = S.next(ui + 1, nxt);
                const char* nA = has_next ? PG8_ABASE(nxt) : cA; const char* nB = has_next ? PG8_BBASE(nxt) : cB;
                for (int t = 0; t < nt; t += 2) { PG8_ADDR(nt); PG8_ITER(PG8_MMA); }
                if (wr == 0) PG8_BAR;
                E(acc, cur, wr, wc, fr, fq);
                if (!has_next) break;
#pragma unroll
                for (int a = 0; a < 2; ++a)
#pragma unroll
                    for (int b = 0; b < 2; ++b)
#pragma unroll
                        for (int m = 0; m < 4; ++m)
#pragma unroll
                            for (int n = 0; n < 2; ++n) acc[a][b][m][n] = acc_t{};
                cur = nxt; cA = nA; cB = nB; ++ui;
                if (wr == 1) PG8_BAR; }
        }
    } else if constexpr (pre_of<Epi>::value) {
        static_assert(!pre_of<Epi>::value || (SP2 && ALIGN_EPI && !Epi::DUAL && !Epi::SPLIT), "streamed epilogue operand: aligned SP2 loop");
        constexpr int PLD = Epi::PRE_LD;
        const size_t hstepP = (size_t)HALF * PLD * 2;
        const float binv = E.pre_scale();
        if constexpr (Epi::PRE_F32) {
            const size_t hstepF = (size_t)HALF * PLD * 4;
            for (;;) {
                const bool has_next = S.next(ui + 1, nxt);
                const char* nA = has_next ? PG8_ABASE(nxt) : cA; const char* nB = has_next ? PG8_BBASE(nxt) : cB;
                for (int t = 0; t < nt - 2; t += 2) {
                    const char* a1 = cA + (size_t)(t + 1) * kstep; const char* a2 = cA + (size_t)(t + 2) * kstep; const char* b2 = cB + (size_t)(t + 2) * kstep; const char* a3 = a2 + kstep; const char* b3 = b2 + kstep;
                    PG8_ITERR(PG8_MMA, voffA, hstep, voffB, hstep); }
                int pm_o = cur.pm, pn_o = cur.pn; asm volatile("" : "+s"(pm_o), "+s"(pn_o));
                const char* pF = (const char*)E.pre_ptr() + ((size_t)pm_o * 256 * PLD + (size_t)pn_o * 256) * 4;
                int tid_p = tid; asm volatile("" : "+v"(tid_p));
                unsigned voffF[2];
#pragma unroll
                for (int i = 0; i < 2; ++i) { int R, C; stage_rc(tid_p * 16 + i * 8192, R, C); voffF[i] = (unsigned)(R * PLD * 4 + C * 2); }
                {   const char* a1 = cA + (size_t)(nt - 1) * kstep; const char* a2 = pF; const char* a3 = pF + 128; const char* b2 = pF + 256; const char* b3 = pF + 384;
                    PG8_ITERR(PG8_MMA, voffF, hstepF, voffF, hstepF); }
                int t_o = tid; asm volatile("" : "+v"(t_o));
                const int pofa = lds_byte(wr * 64 + (t_o & 15), ((t_o & 63) >> 4) * 16), pofb = lds_byte(wr * 64 + (t_o & 15), ((t_o & 63) >> 4) * 16 + 8);
                int wcv = wc; asm volatile("" : "+s"(wcv));
                {   const int wc = wcv;
                    PG8_ITERPF(0, pF + 128, pF + 512, pF + 640, pF + 768, pF + 896, voffF, hstepF, voffF, hstepF);
                    PG8_ITERPF(1, pF + 640, nA, nA + kstep, nB, nB + kstep, voffA, hstep, voffB, hstep); }
                if (wr == 0) PG8_BAR;
                E(acc, cur, wr, wc, fr, fq);
                if (!has_next) break;
#pragma unroll
                for (int a = 0; a < 2; ++a)
#pragma unroll
                    for (int b = 0; b < 2; ++b)
#pragma unroll
                        for (int m = 0; m < 4; ++m)
#pragma unroll
                            for (int n = 0; n < 2; ++n) acc[a][b][m][n] = acc_t{};
                cur = nxt; cA = nA; cB = nB; ++ui;
                if (wr == 1) PG8_BAR;
            }
        } else
        for (;;) {
            const bool has_next = S.next(ui + 1, nxt);
            const char* nA = has_next ? PG8_ABASE(nxt) : cA; const char* nB = has_next ? PG8_BBASE(nxt) : cB;
            const char* pA = (const char*)E.pre_ptr() + ((size_t)cur.pm * 256 * PLD + (size_t)cur.pn * 256) * 2 + (size_t)(cur.pm >> 4) * E.pre_lane();
            for (int t = 0; t < nt - 2; t += 2) {
                const char* a1 = cA + (size_t)(t + 1) * kstep; const char* a2 = cA + (size_t)(t + 2) * kstep; const char* b2 = cB + (size_t)(t + 2) * kstep; const char* a3 = a2 + kstep; const char* b3 = b2 + kstep;
                PG8_ITERR(PG8_MMA, voffA, hstep, voffB, hstep); }
            int tid_p = tid; asm volatile("" : "+v"(tid_p));
            unsigned voffP[2];
#pragma unroll
            for (int i = 0; i < 2; ++i) { int R, C; stage_rc(tid_p * 16 + i * 8192, R, C); voffP[i] = (unsigned)(R * PLD + C) * 2u; }
            {   const char* a1 = cA + (size_t)(nt - 1) * kstep; const char* a2 = pA; const char* a3 = pA + kstep; const char* b2 = pA + 2 * kstep; const char* b3 = pA + 3 * kstep;
                PG8_ITERR(PG8_MMA, voffP, hstepP, voffP, hstepP); }
            int aoff_o = aoff; asm volatile("" : "+v"(aoff_o));
            const int poff = aoff_o + (wc & 1) * 1024;
            u32x4 PA[4], PB0[4], PB1[4];
            PG8_ITERP();
            if (wr == 0) PG8_BAR;
            E(acc, cur, wr, wc, fr, fq);
            if (!has_next) break;
#pragma unroll
            for (int a = 0; a < 2; ++a)
#pragma unroll
                for (int b = 0; b < 2; ++b)
#pragma unroll
                    for (int m = 0; m < 4; ++m)
#pragma unroll
                        for (int n = 0; n < 2; ++n) acc[a][b][m][n] = acc_t{};
            cur = nxt; cA = nA; cB = nB; ++ui;
            if (wr == 1) PG8_BAR;
        }
    } else
    for (;;) {
        const bool has_next = S.next(ui + 1, nxt);
        const char* nA = has_next ? PG8_ABASE(nxt) : cA; const char* nB = has_next ? PG8_BBASE(nxt) : cB;
        for (int t = 0; t < nt; t += 2) {
            const bool last = (t == nt - 2);
            const char* a1 = cA + (size_t)(t + 1) * kstep;
            const char* a2 = last ? nA : cA + (size_t)(t + 2) * kstep; const char* b2 = last ? nB : cB + (size_t)(t + 2) * kstep;
            const char* a3 = a2 + kstep; const char* b3 = b2 + kstep;
#ifdef MK_PROBE_K
            if (blockIdx.x == 0 && tid == 0) { if (t == 2) pk[0] = __builtin_amdgcn_s_memrealtime(); if (t == nt - 2) pk[1] += __builtin_amdgcn_s_memrealtime() - pk[0]; }
#endif
            if constexpr (SP2) {
            bool did1 = false;
            if constexpr (Epi::SPLIT) { if (t == 0 && pending) {
                PG8_STAGE(PG8_SA(1, 1), a1 + hstep, voffA); PG8_SCHED;
                E.half(acc, prev, 1, wr, wc, fr, fq); PG8_ZERO(1); pending = false; PG8_SCHED;
                PG8_LDB(B0, 0, 0); PG8_LDB(B1, 0, 1); PG8_SCHED; PG8_LDA(At, 0, 0); did1 = true; } }
            if (!did1) { PG8_LDB(B0, 0, 0); PG8_LDB(B1, 0, 1); PG8_SCHED; PG8_LDA(At, 0, 0); PG8_STAGE(PG8_SA(1, 1), a1 + hstep, voffA); }
            PG8_WAIT_V(8); PG8_WAIT_L(0); PG8_BAR; PG8_MMA(0, 0, At, B0); PG8_MMA(0, 1, At, B1); PG8_BAR; PG8_SCHED;
            PG8_LDA(At, 0, 1); PG8_STAGE(PG8_SB(0, 0), b2, voffB); PG8_STAGE(PG8_SB(0, 1), b2 + hstep, voffB); PG8_STAGE(PG8_SA(0, 0), a2, voffA);
            PG8_WAIT_V(8); PG8_WAIT_L(0); PG8_BAR; PG8_MMA(1, 0, At, B0); PG8_MMA(1, 1, At, B1); PG8_BAR; PG8_SCHED;
            PG8_LDB(B0, 1, 0); PG8_LDB(B1, 1, 1); PG8_SCHED; PG8_LDA(At, 1, 0); PG8_STAGE(PG8_SA(0, 1), a2 + hstep, voffA);
            PG8_WAIT_V(8); PG8_WAIT_L(0); PG8_BAR; PG8_MMA(0, 0, At, B0); PG8_MMA(0, 1, At, B1); PG8_BAR; PG8_SCHED;
            bool did0 = false;
            if constexpr (Epi::SPLIT) { if (last) {
                PG8_STAGE(PG8_SB(1, 0), b3, voffB); PG8_STAGE(PG8_SB(1, 1), b3 + hstep, voffB); PG8_STAGE(PG8_SA(1, 0), a3, voffA); PG8_SCHED;
                E.half(acc, cur, 0, wr, wc, fr, fq); PG8_ZERO(0); PG8_SCHED;
                PG8_LDA(At, 1, 1); did0 = true; } }
            if (!did0) { PG8_LDA(At, 1, 1); PG8_STAGE(PG8_SB(1, 0), b3, voffB); PG8_STAGE(PG8_SB(1, 1), b3 + hstep, voffB); PG8_STAGE(PG8_SA(1, 0), a3, voffA); }
            PG8_WAIT_V(8); PG8_WAIT_L(0); PG8_BAR; PG8_MMA(1, 0, At, B0); PG8_MMA(1, 1, At, B1); PG8_BAR; PG8_SCHED;
            } else {
            PG8_LDB(B0, 0, 0); PG8_SCHED; PG8_LDA(At, 0, 0); PG8_STAGE(PG8_SA(1, 1), a1 + hstep, voffA);
            PG8_WAIT_L(8); PG8_BAR; PG8_WAIT_L(0); PG8_MMA(0, 0, At, B0); PG8_BAR; PG8_SCHED;
            PG8_LDB(B1, 0, 1); PG8_STAGE(PG8_SB(0, 0), b2, voffB);
            PG8_BAR; PG8_WAIT_L(0); PG8_MMA(0, 1, At, B1); PG8_BAR;
            PG8_LDA(At, 0, 1); PG8_STAGE(PG8_SA(0, 0), a2, voffA);
            PG8_BAR; PG8_WAIT_L(0); PG8_MMA(1, 0, At, B0); PG8_BAR; PG8_SCHED;
            PG8_STAGE(PG8_SB(0, 1), b2 + hstep, voffB);
            PG8_WAIT_V(6); PG8_BAR; PG8_MMA(1, 1, At, B1); PG8_BAR;
            PG8_LDB(B0, 1, 0); PG8_SCHED; PG8_LDA(At, 1, 0); PG8_STAGE(PG8_SA(0, 1), a2 + hstep, voffA);
            PG8_WAIT_L(8); PG8_BAR; PG8_WAIT_L(0); PG8_MMA(0, 0, At, B0); PG8_BAR; PG8_SCHED;
            PG8_LDB(B1, 1, 1); PG8_STAGE(PG8_SB(1, 0), b3, voffB);
            PG8_BAR; PG8_WAIT_L(0); PG8_MMA(0, 1, At, B1); PG8_BAR;
            PG8_LDA(At, 1, 1); PG8_STAGE(PG8_SA(1, 0), a3, voffA);
            PG8_BAR; PG8_WAIT_L(0); PG8_MMA(1, 0, At, B0); PG8_BAR; PG8_SCHED;
            PG8_STAGE(PG8_SB(1, 1), b3 + hstep, voffB);
            PG8_WAIT_V(6); PG8_BAR; PG8_MMA(1, 1, At, B1); PG8_BAR;
            }
        }
        if constexpr (Epi::SPLIT) { static_assert(!Epi::SPLIT || (SP2 && !ALIGN_EPI), "split epilogue: SP2 loop, no alignment barriers"); pending = true; prev = cur; if (!has_next) break; cur = nxt; cA = nA; cB = nB; ++ui; continue; }
        else {
        if constexpr (ALIGN_EPI) { if (wr == 0) PG8_BAR; }
        bool keep = false;
        if constexpr (Epi::DUAL) { if (cur.sel == 0) { E.mid(acc, cur, wr, wc, fr, fq); keep = true; } else E(acc, cur, wr, wc, fr, fq); }
        else E(acc, cur, wr, wc, fr, fq);
        if (!has_next) break;
        if (!keep) {
#pragma unroll
        for (int a = 0; a < 2; ++a)
#pragma unroll
            for (int b = 0; b < 2; ++b)
#pragma unroll
                for (int m = 0; m < 4; ++m)
#pragma unroll
                    for (int n = 0; n < 2; ++n) acc[a][b][m][n] = acc_t{};
        }
        cur = nxt; cA = nA; cB = nB; ++ui;
        if constexpr (ALIGN_EPI) { if (wr == 1) PG8_BAR; }
        }
    }
    if constexpr (Epi::SPLIT) { if (pending) E.half(acc, prev, 1, wr, wc, fr, fq); }
    PG8_WAIT_V(0);
    if constexpr (!ALIGN_EPI) { if (wr == 0) PG8_BAR; }
    PG8_BAR;
#undef PG8_SA
#undef PG8_SB
#undef PG8_STAGE
#undef PG8_LDA
#undef PG8_LDB
#undef PG8_MMA
#undef PG8_MMA_I8
#undef PG8_ADDR
#undef PG8_ITER
#undef PG8_ITERR
#undef PG8_ITERP
#undef PG8_ITERPF
#undef PG8_RAF
#undef PG8_RDP
#undef PG8_ADDP
#undef PG8_WAIT_V
#undef PG8_WAIT_L
#undef PG8_BAR
#undef PG8_SCHED
#undef PG8_ZERO
#undef PG8_ABASE
#undef PG8_BBASE
}
}

#ifndef PG8_SP2
#define PG8_SP2 true
#endif
#ifndef PG8_ALIGN
#define PG8_ALIGN true
#endif

constexpr int NWAVES = 8;
constexpr int BATCH = 8, SEQ = 4096, D = 1024, FF = 2816, DIN = 7168, CA = 31, CB = 3;
constexpr int M = BATCH * SEQ;
constexpr float EPS = 1e-6f;
constexpr int N_PHASES = 9;

constexpr size_t MiB = 1u << 20;
constexpr size_t WS_CTL = 0, CTL_ZERO_BYTES = 192 * 1024;
constexpr size_t CTL_COLMAX1 = 65536, CTL_COLMAX2 = 65536 + 24576;
constexpr int CW_PANEL2 = 32768;
constexpr size_t WS_SSP1 = 1 * MiB, WS_SSP2 = 3 * MiB, WS_SSP3 = 5 * MiB;
constexpr size_t WS_W1 = 8 * MiB, WS_WD1 = 19 * MiB, WS_WIN = 25 * MiB, WS_WA = 39 * MiB, WS_WB = 41 * MiB, WS_WO = 43 * MiB, WS_W2 = 45 * MiB, WS_WD2 = 56 * MiB;
constexpr size_t WS_RA = 64 * MiB;
constexpr size_t WS_Z = 128 * MiB;
constexpr size_t WS_HID = 128 * MiB;
constexpr size_t WS_QA = 448 * MiB;
constexpr size_t WS_XBUF2 = 480 * MiB;
constexpr size_t WS_XBUF3 = 481 * MiB;
constexpr size_t WS_WINQ = 484 * MiB;
constexpr size_t WS_END = 491 * MiB;
constexpr int CW_PANEL3 = 40960;
constexpr size_t WS_SBA = 7 * MiB + 512 * 1024 + 96 * 1024;
constexpr size_t WS_RSA = 2 * MiB;
constexpr size_t WS_SBIN = 7 * MiB + 512 * 1024 + 64 * 1024;
constexpr size_t WS_SB1 = 7 * MiB + 512 * 1024, WS_SB2 = WS_SB1 + 32 * 1024;
constexpr size_t ZS = (size_t)M * D;
constexpr size_t ZK = (size_t)4096 * D, ZX = 2 * ZK, HX = (3 * ZK * 2 - (size_t)4096 * FF * 2) / 2;
constexpr size_t HBX = ZK;
static_assert(WS_W1 + (size_t)2 * FF * D * 2 <= WS_WD1 && WS_WD1 + (size_t)D * FF * 2 <= WS_WIN && WS_WIN + (size_t)DIN * D * 2 <= WS_WA && WS_W2 + (size_t)2 * FF * D * 2 <= WS_WD2 && WS_WD2 + (size_t)D * FF * 2 <= WS_RA, "weights map");
static_assert((size_t)4096 * FF * 2 <= 3 * ZK * 2 && 8 * 3 * ZK == 3 * ZS && WS_Z + 5 * ZS * 2 <= WS_END && HBX * 2 * 2 == (size_t)4096 * D * 4, "activation map: eight 24-MiB sequence slabs (Z0|Z1|Z2, overlaid by that sequence's HID rows), Z3, Z4 behind them; h1 parked in half of the sequence's own output rows");
constexpr int CW_BAR = 1024;
constexpr int CW_LANEXCD = 7168;
constexpr int CW_ROWCTR = 6144;
constexpr int CW_PANEL = 8192;
constexpr size_t WS_XBUF = 7 * MiB;

constexpr int RING_BYTES = 131072;
constexpr int LDSCTL_OFF = RING_BYTES, MISC_OFF = LDSCTL_OFF + 320;
constexpr int LDS_BYTES = 147456;

#define GAS __attribute__((address_space(1)))
#define LAS __attribute__((address_space(3)))
typedef unsigned short bf16;
typedef unsigned v4u __attribute__((ext_vector_type(4)));
typedef unsigned v2u __attribute__((ext_vector_type(2)));
typedef float f32x4 __attribute__((ext_vector_type(4)));
typedef float f32x2 __attribute__((ext_vector_type(2)));
typedef GAS unsigned gu32;
#define RLX_AGENT __ATOMIC_RELAXED, __HIP_MEMORY_SCOPE_AGENT
#define LDS_WAIT() asm volatile("s_waitcnt lgkmcnt(0)" ::: "memory")
#define VM_WAIT() asm volatile("s_waitcnt vmcnt(0)" ::: "memory")
__device__ __forceinline__ unsigned f2bf(float f) { unsigned u = __builtin_bit_cast(unsigned, f); return (u + 0x7fffu + ((u >> 16) & 1u)) >> 16; }
__device__ __forceinline__ unsigned pk2(float lo, float hi) { return f2bf(lo) | (f2bf(hi) << 16); }
__device__ __forceinline__ float bflo(unsigned x) { return __builtin_bit_cast(float, x << 16); }
__device__ __forceinline__ float bfhi(unsigned x) { return __builtin_bit_cast(float, x & 0xffff0000u); }
__device__ __forceinline__ float fast_exp(float x) { return __builtin_amdgcn_exp2f(x * 1.44269504089f); }
__device__ __forceinline__ float fast_rcp(float x) { return __builtin_amdgcn_rcpf(x); }
__device__ __forceinline__ float sigmoidf_(float x) { return fast_rcp(1.0f + fast_exp(-x)); }

#define XB_TMO      128
#define XB_XCNT(j)  (256  + 64 * (j))
#define XB_XSUB(j)  (1280 + 64 * (j))
#define XB_XGEN(j)  (2304 + 64 * (j))
#define XB_TOP      3328
#define XB_TOPGEN   3392
#define XCD_BAR_WORDS 3456
#define XB_SPIN_CAP (1u << 18)
static_assert((CW_BAR + XCD_BAR_WORDS) * 4 <= (int)CTL_ZERO_BYTES, "barrier words inside the memset region");
__device__ __forceinline__ unsigned xb_ld(unsigned* p)              { return __hip_atomic_load(p, __ATOMIC_RELAXED, __HIP_MEMORY_SCOPE_AGENT); }
__device__ __forceinline__ unsigned xb_add(unsigned* p, unsigned v) { return __hip_atomic_fetch_add(p, v, __ATOMIC_RELAXED, __HIP_MEMORY_SCOPE_AGENT); }
__device__ __forceinline__ unsigned xb_xcc_id() { return (unsigned)__builtin_amdgcn_s_getreg((3 << 11) | 20) & 0xFu; }
#define XB_SPIN(cond, bar) do { unsigned _sp = 0; while (cond) { __builtin_amdgcn_s_sleep(1); \
    if ((++_sp & 255u) == 0u) { if (xb_ld(&(bar)[XB_TMO])) break; if (_sp > XB_SPIN_CAP) { atomicAdd(&(bar)[XB_TMO], 1u); break; } } } } while (0)
struct XcdBarrier { unsigned* bar; unsigned x; volatile LAS unsigned* st; };
__device__ __forceinline__ XcdBarrier xcd_barrier_post(unsigned* bar, volatile LAS unsigned* st) {
    XcdBarrier b; b.bar = bar; b.x = xb_xcc_id(); b.st = st;
    if (threadIdx.x == 0) (void)xb_add(&bar[XB_XCNT(b.x)], 1u);
    return b;
}
__device__ __forceinline__ void xcd_barrier_complete(unsigned* bar, unsigned x, unsigned& nloc, unsigned& nx) {
    const unsigned G = gridDim.x * gridDim.y * gridDim.z;
    unsigned sum, cnt, mine, sp = 0u;
    for (;;) {
        sum = 0u; cnt = 0u; mine = 0u;
#pragma unroll
        for (unsigned j = 0; j < 16; ++j) { const unsigned c = xb_ld(&bar[XB_XCNT(j)]); sum += c; cnt += (c > 0u) ? 1u : 0u; mine = (j == x) ? c : mine; }
        if (sum == G) break;
        __builtin_amdgcn_s_sleep(1);
        if ((++sp & 255u) == 0u) { if (xb_ld(&bar[XB_TMO])) break; if (sp > XB_SPIN_CAP) { atomicAdd(&bar[XB_TMO], 1u); break; } }
    }
    nloc = mine > 0u ? mine : 1u; nx = cnt > 0u ? cnt : 1u;
}
__device__ __forceinline__ void xcd_barrier(const XcdBarrier& b) {
    asm volatile("s_waitcnt vmcnt(0)" ::: "memory");
    __syncthreads();
    if (threadIdx.x == 0) {
        unsigned* bar = b.bar;
        __builtin_amdgcn_s_waitcnt(0);
        unsigned nloc = b.st[0], nx = b.st[1];
        if (nloc == 0u) { xcd_barrier_complete(bar, b.x, nloc, nx); b.st[0] = nloc; b.st[1] = nx; }
        const unsigned old = xb_add(&bar[XB_XSUB(b.x)], 1u);
        const unsigned gen = old / nloc;
        if (old + 1u == (gen + 1u) * nloc) {
            __builtin_amdgcn_fence(__ATOMIC_RELEASE, "agent");
            asm volatile("s_waitcnt vmcnt(0)" ::: "memory");
            const unsigned og = xb_add(&bar[XB_TOP], 1u);
            const unsigned tg = og / nx;
            if (og + 1u == (tg + 1u) * nx) xb_add(&bar[XB_TOPGEN], 1u);
            else XB_SPIN(xb_ld(&bar[XB_TOPGEN]) == tg, bar);
            __builtin_amdgcn_fence(__ATOMIC_ACQUIRE, "agent");
            xb_add(&bar[XB_XGEN(b.x)], 1u);
            asm volatile("s_waitcnt vmcnt(0)" ::: "memory");
        } else {
            XB_SPIN(xb_ld(&bar[XB_XGEN(b.x)]) == gen, bar);
            __builtin_amdgcn_fence(__ATOMIC_ACQUIRE, "agent");
            asm volatile("s_waitcnt vmcnt(0)" ::: "memory");
        }
    }
    __syncthreads();
}

__device__ __forceinline__ void xcd_barrier_local(const XcdBarrier& b) {
    asm volatile("s_waitcnt vmcnt(0)" ::: "memory");
    __syncthreads();
    if (threadIdx.x == 0) {
        unsigned* bar = b.bar;
        __builtin_amdgcn_s_waitcnt(0);
        const unsigned nloc = b.st[0];
        asm volatile("buffer_inv sc1" ::: "memory");
        const unsigned old = xb_add(&bar[XB_XSUB(b.x)], 1u);
        const unsigned gen = old / nloc;
        if (old + 1u == (gen + 1u) * nloc) (void)xb_add(&bar[XB_XGEN(b.x)], 1u);
        else XB_SPIN(xb_ld(&bar[XB_XGEN(b.x)]) == gen, bar);
        asm volatile("s_waitcnt vmcnt(0)" ::: "memory");
    }
    __syncthreads();
}

__device__ __forceinline__ float fq_sum(float s) {
    const unsigned u = __builtin_bit_cast(unsigned, s);
    auto r = __builtin_amdgcn_permlane16_swap(u, u, false, false);
    const float t = __builtin_bit_cast(float, (unsigned)r[0]) + __builtin_bit_cast(float, (unsigned)r[1]);
    const unsigned v = __builtin_bit_cast(unsigned, t);
    auto q = __builtin_amdgcn_permlane32_swap(v, v, false, false);
    return __builtin_bit_cast(float, (unsigned)q[0]) + __builtin_bit_cast(float, (unsigned)q[1]);
}
__device__ __forceinline__ float fq_max(float s) {
    const unsigned u = __builtin_bit_cast(unsigned, s);
    auto r = __builtin_amdgcn_permlane16_swap(u, u, false, false);
    const float t = fmaxf(__builtin_bit_cast(float, (unsigned)r[0]), __builtin_bit_cast(float, (unsigned)r[1]));
    const unsigned v = __builtin_bit_cast(unsigned, t);
    auto q = __builtin_amdgcn_permlane32_swap(v, v, false, false);
    return fmaxf(__builtin_bit_cast(float, (unsigned)q[0]), __builtin_bit_cast(float, (unsigned)q[1]));
}
__device__ __forceinline__ unsigned quant4(const f32x4& v, float inv) {
    unsigned u = 0u;
    u = __builtin_amdgcn_cvt_pk_u8_f32(__builtin_rintf(v[0] * inv) + 128.0f, 0, u);
    u = __builtin_amdgcn_cvt_pk_u8_f32(__builtin_rintf(v[1] * inv) + 128.0f, 1, u);
    u = __builtin_amdgcn_cvt_pk_u8_f32(__builtin_rintf(v[2] * inv) + 128.0f, 2, u);
    u = __builtin_amdgcn_cvt_pk_u8_f32(__builtin_rintf(v[3] * inv) + 128.0f, 3, u);
    return u ^ 0x80808080u;
}
__device__ __forceinline__ float row_rstd(const float* ssp, int row, int fq) {
    const f32x4 v = *(const f32x4*)(ssp + (size_t)row * 16 + 4 * fq);
    const float s = fq_sum((v.x + v.y) + (v.z + v.w));
    return rsqrtf(s * (1.0f / D) + EPS);
}
__device__ __forceinline__ v4u pack8(const f32x4& a, const f32x4& b) {
    v4u w; w.x = pg8::cvt_pk_bf16(a[0], a[1]); w.y = pg8::cvt_pk_bf16(a[2], a[3]); w.z = pg8::cvt_pk_bf16(b[0], b[1]); w.w = pg8::cvt_pk_bf16(b[2], b[3]); return w;
}
__device__ __forceinline__ void unpack8(const v4u& w, f32x4& a, f32x4& b) {
    a = (f32x4){bflo(w.x), bfhi(w.x), bflo(w.y), bfhi(w.y)}; b = (f32x4){bflo(w.z), bfhi(w.z), bflo(w.w), bfhi(w.w)};
}
__device__ __forceinline__ f32x2 lo2(const f32x4& v) { return (f32x2){v[0], v[1]}; }
__device__ __forceinline__ f32x2 hi2(const f32x4& v) { return (f32x2){v[2], v[3]}; }
__device__ __forceinline__ f32x4 cat2(const f32x2& a, const f32x2& b) { return (f32x4){a.x, a.y, b.x, b.y}; }
__device__ __forceinline__ f32x2 exp2_2(const f32x2& t) { return (f32x2){__builtin_amdgcn_exp2f(t.x), __builtin_amdgcn_exp2f(t.y)}; }
__device__ __forceinline__ f32x2 rcp_2(const f32x2& t) { return (f32x2){__builtin_amdgcn_rcpf(t.x), __builtin_amdgcn_rcpf(t.y)}; }
__device__ __forceinline__ f32x2 swiglu2(const f32x2& a, const f32x2& b, float c1, float c2i) {
    const f32x2 r = rcp_2(exp2_2(a * c1) * c2i + c2i); return (a * b) * r;
}
__device__ __forceinline__ f32x2 glu2(const f32x2& a, const f32x2& b, float c1, float rsi) {
    const f32x2 r = rcp_2(exp2_2(b * c1) * rsi + rsi); return a * r;
}
__device__ __forceinline__ f32x4 silu_mul4(const f32x4& g, const f32x4& u) {
    f32x4 o;
#pragma unroll
    for (int j = 0; j < 4; ++j) o[j] = g[j] * u[j] * sigmoidf_(g[j]);
    return o;
}
struct RstdStash {
    LAS float* T; const float* ssp; int p0, p1, p2, p3;
    template <class Sched> __device__ __forceinline__ void build(const Sched& S, int wr, int fr, int fq) {
        p0 = p1 = p2 = p3 = -1; int np = 0; pg8::Unit u;
        for (int i = 0; S.next(i, u); ++i) { if (u.pm != p0 && u.pm != p1 && u.pm != p2 && u.pm != p3 && np < 4) {
            if (np == 0) p0 = u.pm; else if (np == 1) p1 = u.pm; else if (np == 2) p2 = u.pm; else p3 = u.pm;
#pragma unroll
            for (int ai = 0; ai < 2; ++ai)
#pragma unroll
                for (int m = 0; m < 4; ++m) { const int rowl = ai * 128 + wr * 64 + m * 16 + fr; T[np * 256 + rowl] = row_rstd(ssp, u.pm * 256 + rowl, fq); }
            ++np; } }
        asm volatile("s_waitcnt vmcnt(0) lgkmcnt(0)" ::: "memory");
    }
    __device__ __forceinline__ int slot(int pm) const { return pm == p0 ? 0 : (pm == p1 ? 1 : (pm == p2 ? 2 : 3)); }
};
struct EpiSwiglu {
    static constexpr bool PERM = true, DUAL = false, SPLIT = false, STASH = true; typedef pg8::f32x4 acc_t;
    __device__ __forceinline__ void operator()(pg8::f32x4 (&acc)[2][2][4][2], const pg8::Unit& u, int wr, int wc, int fr, int fq) const { half(acc, u, 0, wr, wc, fr, fq); half(acc, u, 1, wr, wc, fr, fq); }
    bf16* H; mutable RstdStash st;
    template <class Sched> __device__ __forceinline__ void init(const Sched& S, int wr, int fr, int fq) const { st.build(S, wr, fr, fq); }
    __device__ __forceinline__ void half(pg8::f32x4 (&acc)[2][2][4][2], const pg8::Unit& u, int ai, int wr, int wc, int fr, int fq) const {
        asm volatile("" : "+v"(fr), "+v"(fq));
        const int row0 = u.pm * 256 + wr * 64 + fr, col0 = u.pn * 128 + wc * 32 + 8 * fq; const LAS float* Ts = st.T + st.slot(u.pm) * 256 + ai * 128 + wr * 64 + fr;
        float rsv[4];
#pragma unroll
        for (int m = 0; m < 4; ++m) rsv[m] = Ts[m * 16];
        asm volatile("s_waitcnt lgkmcnt(0)" : "+v"(rsv[0]), "+v"(rsv[1]), "+v"(rsv[2]), "+v"(rsv[3]));
#pragma unroll
        for (int m = 0; m < 4; ++m) {
            const int row = row0 + ai * 128 + m * 16; const float rs = rsv[m];
            const float c1 = rs * -1.44269504089f, c2 = __builtin_amdgcn_rcpf(rs * rs);
            const f32x4 g0 = acc[ai][0][m][0], g1 = acc[ai][0][m][1], u0 = acc[ai][1][m][0], u1 = acc[ai][1][m][1];
            const f32x4 h0 = cat2(swiglu2(lo2(g0), lo2(u0), c1, c2), swiglu2(hi2(g0), hi2(u0), c1, c2)), h1 = cat2(swiglu2(lo2(g1), lo2(u1), c1, c2), swiglu2(hi2(g1), hi2(u1), c1, c2));
            *(v4u*)(H + (size_t)row * FF + (size_t)(u.pm >> 4) * HX + col0) = pack8(h0, h1);
        }
    }
};
struct RowScaleStash {
    LAS float* T; const float* ri; int p0, p1, p2, p3; bool with_amax = true;
    template <class Sched> __device__ __forceinline__ void build(const Sched& S, int wr, int fr, int fq) {
        p0 = p1 = p2 = p3 = -1; int np = 0; pg8::Unit u;
        for (int i = 0; S.next(i, u); ++i) { if (u.pm != p0 && u.pm != p1 && u.pm != p2 && u.pm != p3 && np < 4) {
            if (np == 0) p0 = u.pm; else if (np == 1) p1 = u.pm; else if (np == 2) p2 = u.pm; else p3 = u.pm;
#pragma unroll
            for (int ai = 0; ai < 2; ++ai)
#pragma unroll
                for (int m = 0; m < 4; ++m) { const int rowl = ai * 128 + wr * 64 + m * 16 + fr; const f32x2 v = *(const f32x2*)(ri + 2 * (size_t)(u.pm * 256 + rowl));
                    T[np * 256 + rowl] = rsqrtf(v.x * (1.0f / D) + EPS) * (with_amax ? v.y * (1.0f / 127.0f) : 1.0f); }
            ++np; } }
        asm volatile("s_waitcnt vmcnt(0) lgkmcnt(0)" ::: "memory");
    }
    __device__ __forceinline__ int slot(int pm) const { return pm == p0 ? 0 : (pm == p1 ? 1 : (pm == p2 ? 2 : 3)); }
};
struct EpiSwigluQ {
    static constexpr bool PERM = true, DUAL = false, SPLIT = false, STASH = true; typedef pg8::i32x4 acc_t;
    bf16* H; const float* sB; mutable RowScaleStash st;
    template <class Sched> __device__ __forceinline__ void init(const Sched& S, int wr, int fr, int fq) const { st.build(S, wr, fr, fq); }
    __device__ __forceinline__ void operator()(pg8::i32x4 (&acc)[2][2][4][2], const pg8::Unit& u, int wr, int wc, int fr, int fq) const {
        const int row0 = u.pm * 256 + wr * 64 + fr, col0 = u.pn * 128 + wc * 32 + 8 * fq, gcol = u.pn * 256 + wc * 32 + 8 * fq;
        const f32x4 sg0 = *(const f32x4*)(sB + gcol), sg1 = *(const f32x4*)(sB + gcol + 4), su0 = *(const f32x4*)(sB + gcol + 128), su1 = *(const f32x4*)(sB + gcol + 132);
#pragma unroll
        for (int ai = 0; ai < 2; ++ai) {
            const LAS float* Ts = st.T + st.slot(u.pm) * 256 + ai * 128 + wr * 64 + fr;
            float rsv[4];
#pragma unroll
            for (int m = 0; m < 4; ++m) rsv[m] = Ts[m * 16];
            asm volatile("s_waitcnt lgkmcnt(0)" : "+v"(rsv[0]), "+v"(rsv[1]), "+v"(rsv[2]), "+v"(rsv[3]));
#pragma unroll
            for (int m = 0; m < 4; ++m) {
                const int row = row0 + ai * 128 + m * 16; const float rs = rsv[m];
                const float c1 = rs * -1.44269504089f, c2 = __builtin_amdgcn_rcpf(rs * rs);
                const f32x4 g0 = __builtin_convertvector(acc[ai][0][m][0], f32x4) * sg0, g1 = __builtin_convertvector(acc[ai][0][m][1], f32x4) * sg1;
                const f32x4 u0 = __builtin_convertvector(acc[ai][1][m][0], f32x4) * su0, u1 = __builtin_convertvector(acc[ai][1][m][1], f32x4) * su1;
                const f32x4 h0 = cat2(swiglu2(lo2(g0), lo2(u0), c1, c2), swiglu2(hi2(g0), hi2(u0), c1, c2)), h1 = cat2(swiglu2(lo2(g1), lo2(u1), c1, c2), swiglu2(hi2(g1), hi2(u1), c1, c2));
                *(v4u*)(H + (size_t)row * FF + (size_t)(u.pm >> 4) * HX + col0) = pack8(h0, h1);
            }
        }
    }
};
template <bool BASE_BF16> struct EpiResid {
    static constexpr bool PERM = true, DUAL = false, SPLIT = false, STASH = false; typedef pg8::f32x4 acc_t;
    const float* base; const bf16* baseb; bf16* hb; float* ssp; float alpha;
    __device__ __forceinline__ void operator()(pg8::f32x4 (&acc)[2][2][4][2], const pg8::Unit& u, int wr, int wc, int fr, int fq) const {
        const int row0 = u.pm * 256 + wr * 64 + fr, col0 = u.pn * 256 + wc * 32 + 8 * fq;
        if constexpr (BASE_BF16) {
            v4u rb[2][4][2];
#pragma unroll
            for (int ai = 0; ai < 2; ++ai)
#pragma unroll
                for (int m = 0; m < 4; ++m)
#pragma unroll
                    for (int bj = 0; bj < 2; ++bj) rb[ai][m][bj] = *(const v4u*)(baseb + (size_t)(row0 + ai * 128 + m * 16) * D + col0 + bj * 128);
#pragma unroll
            for (int ai = 0; ai < 2; ++ai)
#pragma unroll
                for (int m = 0; m < 4; ++m) {
                    const int row = row0 + ai * 128 + m * 16; const size_t off = (size_t)row * D + col0; float ss = 0.f;
#pragma unroll
                    for (int bj = 0; bj < 2; ++bj) {
                        f32x4 r0, r1; unpack8(rb[ai][m][bj], r0, r1);
                        const f32x4 v0 = r0 + acc[ai][bj][m][0] * alpha, v1 = r1 + acc[ai][bj][m][1] * alpha;
                        *(v4u*)(hb + off + bj * 128) = pack8(v0, v1);
                        const f32x4 q = v0 * v0 + v1 * v1; ss += (q[0] + q[1]) + (q[2] + q[3]);
                    }
                    ss = fq_sum(ss); if (fq == 0) ssp[(size_t)row * 16 + u.pn * 4 + wc] = ss;
                }
        } else {
#pragma unroll
            for (int ai = 0; ai < 2; ++ai) {
                f32x4 rf[4][2][2];
#pragma unroll
                for (int m = 0; m < 4; ++m)
#pragma unroll
                    for (int bj = 0; bj < 2; ++bj) { const float* p = base + (size_t)(row0 + ai * 128 + m * 16) * D + col0 + bj * 128; rf[m][bj][0] = *(const f32x4*)p; rf[m][bj][1] = *(const f32x4*)(p + 4); }
#pragma unroll
                for (int m = 0; m < 4; ++m) {
                    const int row = row0 + ai * 128 + m * 16; const size_t off = (size_t)row * D + col0; float ss = 0.f;
#pragma unroll
                    for (int bj = 0; bj < 2; ++bj) {
                        const f32x4 v0 = rf[m][bj][0] + acc[ai][bj][m][0] * alpha, v1 = rf[m][bj][1] + acc[ai][bj][m][1] * alpha;
                        *(v4u*)(hb + off + bj * 128) = pack8(v0, v1);
                        const f32x4 q = v0 * v0 + v1 * v1; ss += (q[0] + q[1]) + (q[2] + q[3]);
                    }
                    ss = fq_sum(ss); if (fq == 0) ssp[(size_t)row * 16 + u.pn * 4 + wc] = ss;
                }
                asm volatile("" ::: "memory");
            }
        }
    }
};
template <size_t HBX_, size_t PREX_, bool F32_ = false> struct EpiResidQT {
    static constexpr bool PERM = true, DUAL = false, SPLIT = false, STASH = false, PRE = true, PRE_F32 = F32_; static constexpr int PRE_LD = D; typedef pg8::f32x4 acc_t;
    __device__ __forceinline__ const bf16* pre_ptr() const { return baseb; }
    __device__ __forceinline__ float pre_scale() const { return 1.0f / alpha; }
    __device__ __forceinline__ size_t pre_lane() const { return PREX_; }
    const bf16* baseb; bf16* hb; unsigned char* qa; float* rowinfo; unsigned long long* xbuf; unsigned* cnt; LAS unsigned char* lds; float alpha;
    __device__ __forceinline__ void operator()(pg8::f32x4 (&acc)[2][2][4][2], const pg8::Unit& u, int wr, int wc, int fr, int fq) const {
        int tid = threadIdx.x; asm volatile("" : "+v"(tid), "+v"(fr), "+v"(fq));
        const int lane = tid & 63;
        LAS f32x2* P = (LAS f32x2*)(lds + RING_BYTES + 4096);
        LAS float* S = (LAS float*)(lds + RING_BYTES + 12288);
        const int col0 = u.pn * 256 + wc * 32 + 8 * fq;
#pragma unroll
        for (int ai = 0; ai < 2; ++ai)
#pragma unroll
            for (int m = 0; m < 4; ++m) {
                const int rowl = ai * 128 + wr * 64 + m * 16 + fr; float ss = 0.f, mx = 0.f;
#pragma unroll
                for (int bj = 0; bj < 2; ++bj) {
                    const f32x4 v0 = acc[ai][bj][m][0] * alpha, v1 = acc[ai][bj][m][1] * alpha;
                    acc[ai][bj][m][0] = v0; acc[ai][bj][m][1] = v1;
                    const f32x4 q = v0 * v0 + v1 * v1; ss += (q[0] + q[1]) + (q[2] + q[3]);
                    const f32x4 a0 = __builtin_elementwise_abs(v0), a1 = __builtin_elementwise_abs(v1);
                    mx = fmaxf(mx, fmaxf(fmaxf(fmaxf(a0[0], a0[1]), fmaxf(a0[2], a0[3])), fmaxf(fmaxf(a1[0], a1[1]), fmaxf(a1[2], a1[3]))));
                }
                ss = fq_sum(ss); mx = fq_max(mx); if (fq == 0) P[rowl * 4 + wc] = (f32x2){ss, mx};
            }
        asm volatile("s_waitcnt lgkmcnt(0)" ::: "memory"); __builtin_amdgcn_s_barrier(); asm volatile("" ::: "memory");
        if (tid < 256) { const f32x2 a = P[tid * 4 + 0], b = P[tid * 4 + 1], c = P[tid * 4 + 2], d = P[tid * 4 + 3];
            const float sst = (a.x + b.x) + (c.x + d.x), mxt = fmaxf(fmaxf(a.y, b.y), fmaxf(c.y, d.y));
            __hip_atomic_store(xbuf + ((size_t)(u.pm * 4 + u.pn) * 256 + tid), ((unsigned long long)__builtin_bit_cast(unsigned, mxt) << 32) | __builtin_bit_cast(unsigned, sst), RLX_AGENT); }
        asm volatile("s_waitcnt vmcnt(0)" ::: "memory");
        if (tid < 256 && lane == 0) __hip_atomic_fetch_add(cnt + 64 * u.pm, 1u, RLX_AGENT);
#pragma unroll
        for (int ai = 0; ai < 2; ++ai)
#pragma unroll
            for (int m = 0; m < 4; ++m) {
                const size_t off = (size_t)(u.pm * 256 + ai * 128 + wr * 64 + m * 16 + fr) * D + col0;
#pragma unroll
                for (int bj = 0; bj < 2; ++bj) *(v4u*)(hb + (size_t)(u.pm >> 4) * HBX_ + off + bj * 128) = pack8(acc[ai][bj][m][0], acc[ai][bj][m][1]);
            }
        if (tid < 64) {
            unsigned sp = 0;
            while ((unsigned)__builtin_amdgcn_readfirstlane(__hip_atomic_load(cnt + 64 * u.pm, RLX_AGENT)) < 16u) { __builtin_amdgcn_s_sleep(2); if (++sp > (1u << 22)) break; }
            __builtin_amdgcn_fence(__ATOMIC_ACQUIRE, "agent");
            asm volatile("s_waitcnt vmcnt(0)" ::: "memory");
        }
        asm volatile("s_waitcnt lgkmcnt(0)" ::: "memory"); __builtin_amdgcn_s_barrier(); asm volatile("" ::: "memory");
        if (tid < 256) { float sst = 0.f, mxt = 0.f;
#pragma unroll
            for (int q = 0; q < 4; ++q) { const unsigned long long w = __hip_atomic_load(xbuf + ((size_t)(u.pm * 4 + q) * 256 + tid), RLX_AGENT);
                sst += __builtin_bit_cast(float, (unsigned)w); mxt = fmaxf(mxt, __builtin_bit_cast(float, (unsigned)(w >> 32))); }
            mxt = fmaxf(mxt, 1e-20f);
            S[tid] = 127.0f / mxt;
            if (u.pn == 0) *(f32x2*)(rowinfo + 2 * (size_t)(u.pm * 256 + tid)) = (f32x2){sst, mxt}; }
        asm volatile("s_waitcnt lgkmcnt(0)" ::: "memory"); __builtin_amdgcn_s_barrier(); asm volatile("" ::: "memory");
#pragma unroll
        for (int ai = 0; ai < 2; ++ai)
#pragma unroll
            for (int m = 0; m < 4; m += 2) {
                const int rowl = ai * 128 + wr * 64 + m * 16 + fr; const float inv0 = S[rowl], inv1 = S[rowl + 16];
                const size_t off = (size_t)(u.pm * 256 + rowl + (fq & 1) * 16) * D + col0 - 8 * (fq & 1);
#pragma unroll
                for (int bj = 0; bj < 2; ++bj) {
                    const unsigned a0 = quant4(acc[ai][bj][m][0], inv0), a1 = quant4(acc[ai][bj][m][1], inv0), b0 = quant4(acc[ai][bj][m + 1][0], inv1), b1 = quant4(acc[ai][bj][m + 1][1], inv1);
                    auto rx = __builtin_amdgcn_permlane16_swap(a0, b0, false, false); auto ry = __builtin_amdgcn_permlane16_swap(a1, b1, false, false);
                    v4u w; w.x = rx[0]; w.y = ry[0]; w.z = rx[1]; w.w = ry[1];
                    *(v4u*)(qa + off + bj * 128) = w;
                }
            }
    }
};
struct EpiFinal {
    static constexpr bool PERM = true, DUAL = false, SPLIT = false, STASH = false, PRE = true, PRE_F32 = false; static constexpr int PRE_LD = D; typedef pg8::f32x4 acc_t;
    __device__ __forceinline__ const bf16* pre_ptr() const { return hb; }
    __device__ __forceinline__ float pre_scale() const { return 1.0f / alpha; }
    __device__ __forceinline__ size_t pre_lane() const { return 0; }
    const bf16* hb; float* out; const float* gf; float* xbuf; unsigned* cnt; LAS unsigned char* lds; float alpha; float probe_add;
    __device__ __forceinline__ void operator()(pg8::f32x4 (&acc)[2][2][4][2], const pg8::Unit& u, int wr, int wc, int fr, int fq) const {
        int tid = threadIdx.x; asm volatile("" : "+v"(tid), "+v"(fr), "+v"(fq));
        const int lane = tid & 63;
        LAS float* P = (LAS float*)(lds + RING_BYTES + 4096);
        LAS float* S = (LAS float*)(lds + RING_BYTES + 8192);
        const int col0 = u.pn * 256 + wc * 32 + 8 * fq;
        f32x4 gv[2][2];
#pragma unroll
        for (int bj = 0; bj < 2; ++bj) { gv[bj][0] = *(const f32x4*)(gf + col0 + bj * 128); gv[bj][1] = *(const f32x4*)(gf + col0 + bj * 128 + 4); }
#pragma unroll
        for (int ai = 0; ai < 2; ++ai)
#pragma unroll
            for (int m = 0; m < 4; ++m) {
                const int rowl = ai * 128 + wr * 64 + m * 16 + fr; float ss = 0.f;
#pragma unroll
                for (int bj = 0; bj < 2; ++bj) {
                    const f32x4 v0 = acc[ai][bj][m][0] * alpha, v1 = acc[ai][bj][m][1] * alpha;
                    acc[ai][bj][m][0] = v0 * gv[bj][0]; acc[ai][bj][m][1] = v1 * gv[bj][1];
                    ss += ((v0[0] * v0[0] + v0[1] * v0[1]) + (v0[2] * v0[2] + v0[3] * v0[3])) + ((v1[0] * v1[0] + v1[1] * v1[1]) + (v1[2] * v1[2] + v1[3] * v1[3]));
                }
                ss = fq_sum(ss); if (fq == 0) P[rowl * 4 + wc] = ss;
            }
        asm volatile("s_waitcnt lgkmcnt(0)" ::: "memory"); __builtin_amdgcn_s_barrier(); asm volatile("" ::: "memory");
        if (tid < 256) { const f32x4 p = *(const LAS f32x4*)(P + tid * 4);
            __hip_atomic_store(xbuf + ((size_t)(u.pm * 4 + u.pn) * 256 + tid), (p.x + p.y) + (p.z + p.w), RLX_AGENT); }
        asm volatile("s_waitcnt vmcnt(0)" ::: "memory");
        if (tid < 256 && lane == 0) __hip_atomic_fetch_add(cnt + 64 * u.pm, 1u, RLX_AGENT);
        if (tid < 64) {
            unsigned sp = 0;
            while ((unsigned)__builtin_amdgcn_readfirstlane(__hip_atomic_load(cnt + 64 * u.pm, RLX_AGENT)) < 16u) { __builtin_amdgcn_s_sleep(2); if (++sp > (1u << 22)) break; }
            __builtin_amdgcn_fence(__ATOMIC_ACQUIRE, "agent");
        }
        asm volatile("s_waitcnt vmcnt(0) lgkmcnt(0)" ::: "memory"); __builtin_amdgcn_s_barrier(); asm volatile("" ::: "memory");
        if (tid < 256) { float t = 0.f;
#pragma unroll
            for (int q = 0; q < 4; ++q) t += __hip_atomic_load(xbuf + ((size_t)(u.pm * 4 + q) * 256 + tid), RLX_AGENT);
            S[tid] = rsqrtf(t * (1.0f / D) + EPS); }
        asm volatile("s_waitcnt lgkmcnt(0)" ::: "memory"); __builtin_amdgcn_s_barrier(); asm volatile("" ::: "memory");
#pragma unroll
        for (int ai = 0; ai < 2; ++ai)
#pragma unroll
            for (int m = 0; m < 4; ++m) {
                const int rowl = ai * 128 + wr * 64 + m * 16 + fr; const size_t off = (size_t)(u.pm * 256 + rowl) * D + col0; const float rs = S[rowl];
#pragma unroll
                for (int bj = 0; bj < 2; ++bj) {
                    f32x4 o0 = acc[ai][bj][m][0] * rs, o1 = acc[ai][bj][m][1] * rs;
#ifdef MK_PROBE
                    if (off + bj * 128 == 0) o0[0] += probe_add;
#endif
                    *(f32x4*)(out + off + bj * 128) = o0; *(f32x4*)(out + off + bj * 128 + 4) = o1;
                }
            }
    }
};
struct EpiZin {
    static constexpr bool PERM = true, DUAL = false, SPLIT = false, STASH = true; typedef pg8::f32x4 acc_t;
    typedef RowScaleStash stash_t;
    __device__ __forceinline__ void operator()(pg8::f32x4 (&acc)[2][2][4][2], const pg8::Unit& u, int wr, int wc, int fr, int fq) const { half(acc, u, 0, wr, wc, fr, fq); half(acc, u, 1, wr, wc, fr, fq); }
    bf16* Z; mutable RowScaleStash st;
    template <class Sched> __device__ __forceinline__ void init(const Sched& S, int wr, int fr, int fq) const { st.build(S, wr, fr, fq); }
    __device__ __forceinline__ void half(pg8::f32x4 (&acc)[2][2][4][2], const pg8::Unit& u, int ai, int wr, int wc, int fr, int fq) const {
        asm volatile("" : "+v"(fr), "+v"(fq));
        const int row0 = u.pm * 256 + wr * 64 + fr; const int type = u.pn >> 3;
        const int cpair = (u.pn & 7) * 128 + wc * 32 + 8 * fq, cb = (u.pn - 24) * 256 + wc * 32 + 8 * fq;
        const LAS float* Ts = st.T + st.slot(u.pm) * 256 + ai * 128 + wr * 64 + fr;
        float rsv[4];
#pragma unroll
        for (int m = 0; m < 4; ++m) rsv[m] = Ts[m * 16];
        asm volatile("s_waitcnt lgkmcnt(0)" : "+v"(rsv[0]), "+v"(rsv[1]), "+v"(rsv[2]), "+v"(rsv[3]));
#pragma unroll
        for (int m = 0; m < 4; ++m) {
            const int row = row0 + ai * 128 + m * 16; const float rs = rsv[m];
            const float c1 = rs * -1.44269504089f, c2 = rs * rs;
            const f32x4 p0 = acc[ai][0][m][0], p1 = acc[ai][0][m][1], q0 = acc[ai][1][m][0], q1 = acc[ai][1][m][1];
            if (type == 0) {
                const float rsi = __builtin_amdgcn_rcpf(rs); const f32x4 o0 = cat2(glu2(lo2(p0), lo2(q0), c1, rsi), glu2(hi2(p0), hi2(q0), c1, rsi)), o1 = cat2(glu2(lo2(p1), lo2(q1), c1, rsi), glu2(hi2(p1), hi2(q1), c1, rsi));
                *(v4u*)(Z + (size_t)(u.pm >> 4) * ZX + (size_t)row * D + cpair) = pack8(o0, o1);
            } else if (type == 1) {
                *(v4u*)(Z + ZK + (size_t)(u.pm >> 4) * ZX + (size_t)row * D + cpair) = pack8((p0 * q0) * c2, (p1 * q1) * c2);
            } else if (type == 2) {
                f32x4 r[2], sg[2];
#pragma unroll
                for (int h = 0; h < 2; ++h) {
                    const f32x4 pa = h ? p1 : p0, qa = h ? q1 : q0;
                    f32x4 ta = pa * c1, tb = qa * c1;
#pragma unroll
                    for (int j = 0; j < 4; ++j) { ta[j] = __builtin_amdgcn_fmed3f(ta[j], -86.56f, 86.56f); tb[j] = __builtin_amdgcn_fmed3f(tb[j], -86.56f, 86.56f); }
                    const f32x2 dal = exp2_2(lo2(ta)) + 1.0f, dah = exp2_2(hi2(ta)) + 1.0f, dbl = exp2_2(lo2(tb)) + 1.0f, dbh = exp2_2(hi2(tb)) + 1.0f;
                    r[h] = cat2(dbl * rcp_2(dal), dbh * rcp_2(dah)); sg[h] = cat2(rcp_2(dbl), rcp_2(dbh));
                }
                *(v4u*)(Z + 3 * ZS + (size_t)row * D + cpair) = pack8(r[0], r[1]);
                *(v4u*)(Z + 4 * ZS + (size_t)row * D + cpair) = pack8(sg[0], sg[1]);
            } else {
                *(v4u*)(Z + 2 * ZK + (size_t)(u.pm >> 4) * ZX + (size_t)row * D + cb) = pack8(p0 * rs, p1 * rs);
                *(v4u*)(Z + 2 * ZK + (size_t)(u.pm >> 4) * ZX + (size_t)row * D + cb + 128) = pack8(q0 * rs, q1 * rs);
            }
        }
    }
};
struct EpiZinQ {
    static constexpr bool PERM = true, DUAL = false, SPLIT = false, STASH = true; typedef pg8::i32x4 acc_t;
    typedef RowScaleStash stash_t;
    __device__ __forceinline__ void operator()(pg8::i32x4 (&acc)[2][2][4][2], const pg8::Unit& u, int wr, int wc, int fr, int fq) const { half(acc, u, 0, wr, wc, fr, fq); half(acc, u, 1, wr, wc, fr, fq); }
    bf16* Z; const float* sB; mutable RowScaleStash st;
    template <class Sched> __device__ __forceinline__ void init(const Sched& S, int wr, int fr, int fq) const { st.build(S, wr, fr, fq); }
    __device__ __forceinline__ void half(pg8::i32x4 (&acc)[2][2][4][2], const pg8::Unit& u, int ai, int wr, int wc, int fr, int fq) const {
        asm volatile("" : "+v"(fr), "+v"(fq));
        const int row0 = u.pm * 256 + wr * 64 + fr; const int type = u.pn >> 3;
        const int cpair = (u.pn & 7) * 128 + wc * 32 + 8 * fq, cb = (u.pn - 24) * 256 + wc * 32 + 8 * fq;
        const LAS float* Ts = st.T + st.slot(u.pm) * 256 + ai * 128 + wr * 64 + fr;
        const int gcol = u.pn * 256 + wc * 32 + 8 * fq;
        const f32x4 sp0 = *(const f32x4*)(sB + gcol), sp1 = *(const f32x4*)(sB + gcol + 4), sq0 = *(const f32x4*)(sB + gcol + 128), sq1 = *(const f32x4*)(sB + gcol + 132);
        float rsv[4];
#pragma unroll
        for (int m = 0; m < 4; ++m) rsv[m] = Ts[m * 16];
        asm volatile("s_waitcnt lgkmcnt(0)" : "+v"(rsv[0]), "+v"(rsv[1]), "+v"(rsv[2]), "+v"(rsv[3]));
#pragma unroll
        for (int m = 0; m < 4; ++m) {
            const int row = row0 + ai * 128 + m * 16; const float rs = rsv[m];
            const float c1 = rs * -1.44269504089f, c2 = rs * rs;
            const f32x4 p0 = __builtin_convertvector(acc[ai][0][m][0], f32x4) * sp0, p1 = __builtin_convertvector(acc[ai][0][m][1], f32x4) * sp1;
            const f32x4 q0 = __builtin_convertvector(acc[ai][1][m][0], f32x4) * sq0, q1 = __builtin_convertvector(acc[ai][1][m][1], f32x4) * sq1;
            if (type == 0) {
                const float rsi = __builtin_amdgcn_rcpf(rs); const f32x4 o0 = cat2(glu2(lo2(p0), lo2(q0), c1, rsi), glu2(hi2(p0), hi2(q0), c1, rsi)), o1 = cat2(glu2(lo2(p1), lo2(q1), c1, rsi), glu2(hi2(p1), hi2(q1), c1, rsi));
                *(v4u*)(Z + (size_t)(u.pm >> 4) * ZX + (size_t)row * D + cpair) = pack8(o0, o1);
            } else if (type == 1) {
                *(v4u*)(Z + ZK + (size_t)(u.pm >> 4) * ZX + (size_t)row * D + cpair) = pack8((p0 * q0) * c2, (p1 * q1) * c2);
            } else if (type == 2) {
                f32x4 r[2], sg[2];
#pragma unroll
                for (int h = 0; h < 2; ++h) {
                    const f32x4 pa = h ? p1 : p0, qa = h ? q1 : q0;
                    f32x4 ta = pa * c1, tb = qa * c1;
#pragma unroll
                    for (int j = 0; j < 4; ++j) { ta[j] = __builtin_amdgcn_fmed3f(ta[j], -86.56f, 86.56f); tb[j] = __builtin_amdgcn_fmed3f(tb[j], -86.56f, 86.56f); }
                    const f32x2 dal = exp2_2(lo2(ta)) + 1.0f, dah = exp2_2(hi2(ta)) + 1.0f, dbl = exp2_2(lo2(tb)) + 1.0f, dbh = exp2_2(hi2(tb)) + 1.0f;
                    r[h] = cat2(dbl * rcp_2(dal), dbh * rcp_2(dah)); sg[h] = cat2(rcp_2(dbl), rcp_2(dbh));
                }
                *(v4u*)(Z + 3 * ZS + (size_t)row * D + cpair) = pack8(r[0], r[1]);
                *(v4u*)(Z + 4 * ZS + (size_t)row * D + cpair) = pack8(sg[0], sg[1]);
            } else {
                *(v4u*)(Z + 2 * ZK + (size_t)(u.pm >> 4) * ZX + (size_t)row * D + cb) = pack8(p0 * rs, p1 * rs);
                *(v4u*)(Z + 2 * ZK + (size_t)(u.pm >> 4) * ZX + (size_t)row * D + cb + 128) = pack8(q0 * rs, q1 * rs);
            }
        }
    }
};
struct EpiMix {
    static constexpr bool PERM = true, DUAL = true, SPLIT = false, STASH = false, MIXED = true; typedef pg8::f32x4 acc_t;
    const bf16* ratio; const bf16* sgb; bf16* O; const float* rsA; const float* sBa;
    __device__ __forceinline__ void mid(pg8::f32x4 (&acc)[2][2][4][2], const pg8::Unit& u, int wr, int wc, int fr, int fq) const {
        const int row0 = u.pm * 256 + wr * 64 + fr, col0 = u.pn * 256 + wc * 32 + 8 * fq;
        f32x4 sc[2][2]; float rsv[2][4];
#pragma unroll
        for (int bj = 0; bj < 2; ++bj) { sc[bj][0] = *(const f32x4*)(sBa + col0 + bj * 128); sc[bj][1] = *(const f32x4*)(sBa + col0 + bj * 128 + 4); }
#pragma unroll
        for (int ai = 0; ai < 2; ++ai)
#pragma unroll
            for (int m = 0; m < 4; ++m) rsv[ai][m] = rsA[row0 + ai * 128 + m * 16];
        v4u gb[2][4][2];
#pragma unroll
        for (int ai = 0; ai < 2; ++ai)
#pragma unroll
            for (int m = 0; m < 4; ++m)
#pragma unroll
                for (int bj = 0; bj < 2; ++bj) gb[ai][m][bj] = *(const v4u*)(ratio + (size_t)(row0 + ai * 128 + m * 16) * D + col0 + bj * 128);
#pragma unroll
        for (int ai = 0; ai < 2; ++ai)
#pragma unroll
            for (int m = 0; m < 4; ++m)
#pragma unroll
                for (int bj = 0; bj < 2; ++bj) { f32x4 a, b; unpack8(gb[ai][m][bj], a, b); const float rs = rsv[ai][m];
                    acc[ai][bj][m][0] = __builtin_convertvector(__builtin_bit_cast(pg8::i32x4, acc[ai][bj][m][0]), f32x4) * (a * (sc[bj][0] * rs));
                    acc[ai][bj][m][1] = __builtin_convertvector(__builtin_bit_cast(pg8::i32x4, acc[ai][bj][m][1]), f32x4) * (b * (sc[bj][1] * rs)); }
    }
    __device__ __forceinline__ void operator()(pg8::f32x4 (&acc)[2][2][4][2], const pg8::Unit& u, int wr, int wc, int fr, int fq) const {
        const int row0 = u.pm * 256 + wr * 64 + fr, col0 = u.pn * 256 + wc * 32 + 8 * fq;
        v4u gb[2][4][2];
#pragma unroll
        for (int ai = 0; ai < 2; ++ai)
#pragma unroll
            for (int m = 0; m < 4; ++m)
#pragma unroll
                for (int bj = 0; bj < 2; ++bj) gb[ai][m][bj] = *(const v4u*)(sgb + (size_t)(row0 + ai * 128 + m * 16) * D + col0 + bj * 128);
#pragma unroll
        for (int ai = 0; ai < 2; ++ai)
#pragma unroll
            for (int m = 0; m < 4; ++m) {
                const size_t off = (size_t)(row0 + ai * 128 + m * 16) * D + col0;
#pragma unroll
                for (int bj = 0; bj < 2; ++bj) { f32x4 a, b; unpack8(gb[ai][m][bj], a, b);
                    *(v4u*)(O + (size_t)(u.pm >> 4) * ZX + off + bj * 128) = pack8(acc[ai][bj][m][0] * a, acc[ai][bj][m][1] * b); }
            }
    }
};

__device__ __forceinline__ float wave_sum(float v) {
#pragma unroll
    for (int o = 1; o < 64; o <<= 1) v += __shfl_xor(v, o);
    return v;
}
__device__ __forceinline__ void p0_transpose_item(const float* W, const float* gain, int K, int N, bf16* WT, int k0, int n0, int drow, LAS unsigned short* scr, int lane) {
    const int kr = lane >> 4, nc = lane & 15;
    f32x4 v[16];
#pragma unroll
    for (int i = 0; i < 16; ++i) v[i] = *(const GAS f32x4*)(W + (size_t)(k0 + 4 * i + kr) * N + n0 + 4 * nc);
#pragma unroll
    for (int i = 0; i < 16; ++i) { const int k = 4 * i + kr; const float gk = gain ? gain[k0 + k] : 1.0f; const f32x4 w = v[i] * gk;
        LAS unsigned* d = (LAS unsigned*)(scr + k * 66 + 4 * nc); d[0] = pk2(w.x, w.y); d[1] = pk2(w.z, w.w); }
    LDS_WAIT(); asm volatile("" ::: "memory");
    const int c = lane & 7;
#pragma unroll
    for (int j = 0; j < 8; ++j) { const int n = (lane >> 3) + 8 * j; const LAS unsigned short* sp = scr + (8 * c) * 66 + n;
        v4u o; o.x = (unsigned)sp[0] | ((unsigned)sp[66] << 16); o.y = (unsigned)sp[2 * 66] | ((unsigned)sp[3 * 66] << 16);
        o.z = (unsigned)sp[4 * 66] | ((unsigned)sp[5 * 66] << 16); o.w = (unsigned)sp[6 * 66] | ((unsigned)sp[7 * 66] << 16);
        *(GAS v4u*)(WT + (size_t)(drow + n) * K + k0 + 8 * c) = o; }
    LDS_WAIT(); asm volatile("" ::: "memory");
}
__device__ __forceinline__ int dest_row(int mode, int n0) {
    if (mode == 0) return n0;
    if (mode == 1) return 256 * (n0 >> 7) + (n0 & 127);
    if (mode == 2) return 256 * (n0 >> 7) + 128 + (n0 & 127);
    const int s = n0 >> 10, j = n0 & 1023, pj = 256 * (j >> 7) + (j & 127);
    switch (s) {
        case 0: return pj;
        case 1: return pj + 128;
        case 2: return 6144 + j;
        case 3: return 2048 + pj;
        case 4: return 2048 + pj + 128;
        case 5: return 4096 + pj;
        default: return 4096 + pj + 128;
    }
}
__device__ __forceinline__ void p0_weight(const float* W, const float* gain, int K, int N, bf16* WT, int mode, int item, LAS unsigned short* scr, int lane) {
    const int nblk = N / 64, kb = item / nblk, nb = item % nblk;
    p0_transpose_item(W, gain, K, N, WT, 64 * kb, 64 * nb, dest_row(mode, 64 * nb), scr, lane);
}

__device__ __forceinline__ void p0_quant_unit(const float* W, const float* gain, int N, unsigned char* WTq, int ldq, int n0, int drow, float* sB, LAS unsigned char* lds, int wave, int lane) {
    constexpr int K = D;
    const int kr = lane >> 4, nc = lane & 15;
    LAS f32x4* tbl = (LAS f32x4*)(lds + RING_BYTES + 1024);
    LAS unsigned char* scr = lds + wave * 16384;
    f32x4 v[2][16]; f32x4 mx = (f32x4){0.f, 0.f, 0.f, 0.f};
#pragma unroll
    for (int t = 0; t < 2; ++t)
#pragma unroll
        for (int i = 0; i < 16; ++i) v[t][i] = *(const GAS f32x4*)(W + (size_t)((2 * wave + t) * 64 + 4 * i + kr) * N + n0 + 4 * nc);
#pragma unroll
    for (int t = 0; t < 2; ++t)
#pragma unroll
        for (int i = 0; i < 16; ++i) { if (gain) v[t][i] = v[t][i] * gain[(2 * wave + t) * 64 + 4 * i + kr]; const f32x4 a = __builtin_elementwise_abs(v[t][i]);
            mx = (f32x4){fmaxf(mx[0], a[0]), fmaxf(mx[1], a[1]), fmaxf(mx[2], a[2]), fmaxf(mx[3], a[3])}; }
#pragma unroll
    for (int e = 0; e < 4; ++e) mx[e] = fq_max(mx[e]);
    if (kr == 0) tbl[wave * 16 + nc] = mx;
    __syncthreads();
    f32x4 cm = tbl[nc];
#pragma unroll
    for (int w = 1; w < 8; ++w) { const f32x4 o = tbl[w * 16 + nc]; cm = (f32x4){fmaxf(cm[0], o[0]), fmaxf(cm[1], o[1]), fmaxf(cm[2], o[2]), fmaxf(cm[3], o[3])}; }
    cm = (f32x4){fmaxf(cm[0], 1e-30f), fmaxf(cm[1], 1e-30f), fmaxf(cm[2], 1e-30f), fmaxf(cm[3], 1e-30f)};
    const f32x4 inv = (f32x4){127.0f / cm[0], 127.0f / cm[1], 127.0f / cm[2], 127.0f / cm[3]};
    if (wave == 0 && kr == 0) *(GAS f32x4*)(sB + drow + 4 * nc) = cm * (1.0f / 127.0f);
    const int c = lane & 3;
#pragma unroll
    for (int t = 0; t < 2; ++t) {
        const int k0 = (2 * wave + t) * 64;
#pragma unroll
        for (int i = 0; i < 16; ++i) *(LAS unsigned*)(scr + (4 * i + kr) * 68 + 4 * nc) = quant4(v[t][i] * inv, 1.0f);
        LDS_WAIT(); asm volatile("" ::: "memory");
#pragma unroll
        for (int j = 0; j < 4; ++j) { const int n = (lane >> 2) + 16 * j; const LAS unsigned char* sp = scr + (16 * c) * 68 + n; unsigned w[4];
#pragma unroll
            for (int d = 0; d < 4; ++d) w[d] = (unsigned)sp[(4 * d) * 68] | ((unsigned)sp[(4 * d + 1) * 68] << 8) | ((unsigned)sp[(4 * d + 2) * 68] << 16) | ((unsigned)sp[(4 * d + 3) * 68] << 24);
            *(GAS v4u*)(WTq + (size_t)(drow + n) * ldq + k0 + 16 * c) = (v4u){w[0], w[1], w[2], w[3]}; }
        LDS_WAIT(); asm volatile("" ::: "memory");
    }
    __syncthreads();
}
struct Args { const float* in[20]; float* out; unsigned char* ws; int ph_lo, ph_hi, use_bar, skip_b; };

__global__ void __launch_bounds__(NWAVES * 64, 2) mk_fwd(Args args) {
    extern __shared__ __attribute__((aligned(16))) unsigned char lds_raw[];
    LAS unsigned char* lds = (LAS unsigned char*)lds_raw;
    volatile LAS unsigned* MISC = (volatile LAS unsigned*)(lds + MISC_OFF);
    const int tid = threadIdx.x, lane = tid & 63, wave = __builtin_amdgcn_readfirstlane(tid >> 6);
    const int G = gridDim.x; const int bx = blockIdx.x; const int vcu = (G % 8 == 0) ? (bx % 8) * (G / 8) + bx / 8 : bx;
    unsigned char* ws = args.ws;
    gu32* ctl = (gu32*)(ws + WS_CTL);
    const float* x = args.in[0];
    float* out = args.out;
    float* ssp1 = (float*)(ws + WS_SSP1); float* ssp2 = (float*)(ws + WS_SSP2); float* ssp3 = (float*)(ws + WS_SSP3);
    bf16* W1 = (bf16*)(ws + WS_W1); bf16* WD1 = (bf16*)(ws + WS_WD1); bf16* WIN = (bf16*)(ws + WS_WIN); bf16* WA = (bf16*)(ws + WS_WA); bf16* WB = (bf16*)(ws + WS_WB);
    bf16* WO = (bf16*)(ws + WS_WO); bf16* W2 = (bf16*)(ws + WS_W2); bf16* WD2 = (bf16*)(ws + WS_WD2);
    bf16* RA = (bf16*)(ws + WS_RA); bf16* Z = (bf16*)(ws + WS_Z); bf16* HID = (bf16*)(ws + WS_HID);
    unsigned char* QA = ws + WS_QA; unsigned char* W1q = ws + WS_W1; unsigned char* W2q = ws + WS_W2;
    float* sB1 = (float*)(ws + WS_SB1); float* sB2 = (float*)(ws + WS_SB2);
    unsigned char* WINq = ws + WS_WINQ; float* sBin = (float*)(ws + WS_SBIN); float* rowinfo2 = ssp2;
    unsigned char* WAq = ws + WS_WA; float* sBa = (float*)(ws + WS_SBA); float* rsA = (float*)(ws + WS_RSA);
    float* rowinfo1 = ssp1; float* rowinfo3 = ssp3;
    bf16* HB1 = (bf16*)out;

    for (int u = tid; u < (LDS_BYTES - LDSCTL_OFF) / 4; u += NWAVES * 64) ((LAS unsigned*)(lds + LDSCTL_OFF))[u] = 0u;
    __syncthreads();
    XcdBarrier bar; bar.bar = (unsigned*)(ctl + CW_BAR); bar.x = 0; bar.st = nullptr;
    if (args.use_bar) { bar = xcd_barrier_post((unsigned*)(ctl + CW_BAR), MISC + 8);
        if (tid == 0) (void)__hip_atomic_fetch_or((unsigned*)(ctl + CW_LANEXCD) + 64 * (bx & 7), 1u << bar.x, __ATOMIC_RELAXED, __HIP_MEMORY_SCOPE_AGENT); }
    bool seam_local = false;
    const int lo = args.ph_lo, hi = args.ph_hi;
#define IN(k) (lo <= (k) && (k) < hi)
#ifdef MK_PROBE
    unsigned long long* const stamps = (unsigned long long*)(ws + 20480);
#define PSAVE(p) do { if (bx == 0 && tid == 0) { LAS unsigned long long* pk_ = (LAS unsigned long long*)(lds + 131072 + 64); stamps[16 + (p)] = pk_[1]; pk_[1] = 0ull; } } while (0)
#define SEAM(k) do { if (IN(k) && IN((k) + 1)) xcd_barrier(bar); if (bx == 0 && tid == 0) __hip_atomic_store(stamps + (k) + 1, __builtin_amdgcn_s_memrealtime(), RLX_AGENT); } while (0)
#define SEAM_L(k) do { if (IN(k) && IN((k) + 1)) { if (seam_local) xcd_barrier_local(bar); else xcd_barrier(bar); } if (bx == 0 && tid == 0) __hip_atomic_store(stamps + (k) + 1, __builtin_amdgcn_s_memrealtime(), RLX_AGENT); } while (0)
    if (bx == 0 && tid == 0) __hip_atomic_store(stamps, __builtin_amdgcn_s_memrealtime(), RLX_AGENT);
#else
#define PSAVE(p) do { } while (0)
#define SEAM(k) do { if (IN(k) && IN((k) + 1)) xcd_barrier(bar); } while (0)
#define SEAM_L(k) do { if (IN(k) && IN((k) + 1)) { if (seam_local) xcd_barrier_local(bar); else xcd_barrier(bar); } } while (0)
#endif

    if (IN(0)) {
        LAS unsigned short* scr = (LAS unsigned short*)(lds + wave * 16384);
        const int gw = vcu * NWAVES + wave, NGW = G * NWAVES;
        constexpr int I_GU = (D / 64) * (FF / 64), I_DN = (FF / 64) * (D / 64), I_IN = (D / 64) * (2 * D / 64)  , I_SQ = (D / 64) * (D / 64);
        constexpr int NITEMS = 4 * I_GU + 2 * I_DN + I_IN + 2 * I_SQ;
        constexpr int NQF = (MK_Q2 ? 4 : 2) * (FF / 64), NQW = NQF + 80, NQU = NQW + 16;
        for (int uq = vcu; uq < NQU; uq += G) {
            const float* Wp; const float* gp; unsigned char* Wq; float* sBp; int Nq, n0, mode, ldq = D;
            if (uq >= NQW) { n0 = 64 * (uq - NQW); Wp = args.in[11]; gp = nullptr; Wq = WAq; sBp = sBa; Nq = D; mode = 0; ldq = 2 * D; }
            else if (uq >= NQF) { const int q = uq - NQF, sg = q >> 4, seg = sg < 3 ? sg : sg + 2; n0 = seg * 1024 + 64 * (q & 15); Wp = args.in[6]; gp = args.in[5]; Wq = WINq; sBp = sBin; Nq = DIN; mode = 3; }
            else { const int w = uq / (FF / 64); n0 = 64 * (uq - w * (FF / 64)); Wp = w == 0 ? args.in[2] : (w == 1 ? args.in[3] : (w == 2 ? args.in[16] : args.in[17]));
                gp = w < 2 ? args.in[1] : args.in[15]; Wq = w < 2 ? W1q : W2q; sBp = w < 2 ? sB1 : sB2; Nq = FF; mode = 1 + (w & 1); }
            p0_quant_unit(Wp, gp, Nq, Wq, ldq, n0, dest_row(mode, n0), sBp, lds, wave, lane);
        }
        constexpr int NREST = NITEMS - 4 * I_GU + (MK_Q2 ? 0 : 2 * I_GU);
        const int nunit_wg = NQU < G ? NQU : G;
        const int nd = NQU > G ? NQU - G : 0;
        const int slots = (vcu < nd) ? 0 : ((vcu < nunit_wg) ? 1 : 2);
        const int vslot0 = (vcu < nunit_wg) ? (vcu - nd) * NWAVES + wave : (nunit_wg - nd) * NWAVES + ((vcu - nunit_wg) * NWAVES + wave) * 2;
        const int NVS = (nunit_wg - nd) * NWAVES + (G - nunit_wg) * NWAVES * 2;
        if (slots > 0)
        for (int it0 = vslot0; it0 < NREST; it0 += NVS)
        for (int sl = 0; sl < slots; ++sl) {
            int r = it0 + sl; if (r >= NREST) break;
            if (!MK_Q2) {
                if (r < I_GU) { p0_weight(args.in[16], args.in[15], D, FF, W2, 1, r, scr, lane); continue; } r -= I_GU;
                if (r < I_GU) { p0_weight(args.in[17], args.in[15], D, FF, W2, 2, r, scr, lane); continue; } r -= I_GU;
            }
            if (r < I_DN) { p0_weight(args.in[4], nullptr, FF, D, WD1, 0, r, scr, lane); continue; } r -= I_DN;
            if (r < I_IN) { const int kb = r / 32, n0 = 3072 + 64 * (r - kb * 32); p0_transpose_item(args.in[6], args.in[5], D, DIN, WIN, 64 * kb, n0, dest_row(3, n0), scr, lane); continue; } r -= I_IN;
            if (r < I_SQ) { p0_weight(args.in[13], nullptr, D, D, WB, 0, r, scr, lane); continue; } r -= I_SQ;
            if (r < I_SQ) { p0_weight(args.in[14], nullptr, D, D, WO, 0, r, scr, lane); continue; } r -= I_SQ;
            p0_weight(args.in[18], nullptr, FF, D, WD2, 0, r, scr, lane);
        }
        const bool dynrows = (G == 256);
        constexpr int TAIL0 = 3 * (M / 4), TGROUPS = (M / 4) / 4 / 8;
        unsigned* const rowctr = (unsigned*)(ctl + CW_ROWCTR) + 64 * (bx & 7);
        int nextg = 0;
        for (int it = 0;; ++it) {
            int m0, ms;
            if (!dynrows || it < 3) { m0 = gw + it * 4 * NGW; ms = NGW; if (m0 >= M) break;
                if (dynrows && it == 2) { int t_ = 0; if (lane == 0) t_ = (int)__hip_atomic_fetch_add(rowctr, 1u, RLX_AGENT); nextg = __builtin_amdgcn_readfirstlane(t_); } }
            else { const int gsel = nextg; if (gsel >= TGROUPS) break; m0 = TAIL0 + ((bx & 7) * TGROUPS + gsel) * 4; ms = 1;
                { int t_ = 0; if (lane == 0) t_ = (int)__hip_atomic_fetch_add(rowctr, 1u, RLX_AGENT); nextg = __builtin_amdgcn_readfirstlane(t_); } }
            f32x4 v[4][4];
#pragma unroll
            for (int r = 0; r < 4; ++r) { const int m = m0 + r * ms; if (m < M) { const GAS f32x4* xr = (const GAS f32x4*)(x + (size_t)m * D) + lane;
#pragma unroll
                for (int j = 0; j < 4; ++j) v[r][j] = xr[64 * j]; } }
#pragma unroll
            for (int r = 0; r < 4; ++r) { const int m = m0 + r * ms; if (m < M) { float sq = 0.f, mx = 0.f;
#pragma unroll
                for (int j = 0; j < 4; ++j) { sq += (v[r][j].x * v[r][j].x + v[r][j].y * v[r][j].y) + (v[r][j].z * v[r][j].z + v[r][j].w * v[r][j].w);
                    const f32x4 a = __builtin_elementwise_abs(v[r][j]); mx = fmaxf(mx, fmaxf(fmaxf(a.x, a.y), fmaxf(a.z, a.w))); }
                sq = wave_sum(sq);
#pragma unroll
                for (int o = 1; o < 64; o <<= 1) mx = fmaxf(mx, __shfl_xor(mx, o));
                mx = fmaxf(mx, 1e-20f); const float inv = 127.0f / mx;
                GAS unsigned* q4 = (GAS unsigned*)(QA + (size_t)m * D) + lane;
#pragma unroll
                for (int j = 0; j < 4; ++j) q4[64 * j] = quant4(v[r][j], inv);
                if (lane == 0) *(GAS f32x2*)(rowinfo1 + 2 * (size_t)m) = (f32x2){sq, mx}; } }
        }
    }
    SEAM(0);
    if (args.use_bar && IN(0) && IN(1)) {
        if (tid == 0) { unsigned ok = (G == 256) ? 1u : 0u;
#pragma unroll
            for (int j = 0; j < 8; ++j) { const unsigned m = xb_ld((unsigned*)(ctl + CW_LANEXCD) + 64 * j); ok &= (m != 0u && (m & (m - 1u)) == 0u) ? 1u : 0u; }
            MISC[10] = ok; }
        __syncthreads();
        seam_local = MISC[10] != 0u;
    }
    if (IN(1)) {
        pg8::Gemm g{(const bf16*)QA, (const bf16*)W1q, nullptr, nullptr, M, 2 * FF, D / 2}; pg8::StaticOrderT<M / 256, 2 * FF / 256> S; S.init(G, bx);
        EpiSwigluQ E{HID, sB1, RowScaleStash{(LAS float*)(lds + RING_BYTES + 1024), rowinfo1, -1, -1, -1, -1}};
        pg8::gemm_phase<EpiSwigluQ, pg8::StaticOrderT<M / 256, 2 * FF / 256>, true, true>(lds, g, S, E); PSAVE(1);
    }
    SEAM_L(1);
    if (IN(2)) {
        pg8::Gemm g{HID, WD1, nullptr, nullptr, M, D, FF, HX * 2, 0}; pg8::StaticOrderT<M / 256, D / 256> S; S.init(G, bx);
        typedef EpiResidQT<HBX, 0, true> EpiResidQ2;
        EpiResidQ2 E{(const bf16*)x, HB1, QA, rowinfo2, (unsigned long long*)(ws + WS_XBUF3), (unsigned*)(ctl + CW_PANEL3), lds, 0.5f};
        pg8::gemm_phase<EpiResidQ2, pg8::StaticOrderT<M / 256, D / 256>, PG8_ALIGN, PG8_SP2>(lds, g, S, E); PSAVE(2);
    }
    SEAM_L(2);
    if (IN(3)) {
        {   pg8::Gemm g{(const bf16*)QA, (const bf16*)WINq, nullptr, nullptr, M, DIN, D / 2}; pg8::MapOrderT<M / 256, 20, 0> S; S.init(G, bx);
            EpiZinQ E{Z, sBin, RowScaleStash{(LAS float*)(lds + RING_BYTES + 1024), rowinfo2, -1, -1, -1, -1, true}};
            pg8::gemm_phase<EpiZinQ, pg8::MapOrderT<M / 256, 20, 0>, true, true>(lds, g, S, E); }
        {   pg8::Gemm g{HB1, WIN, nullptr, nullptr, M, DIN, D, HBX * 2, 0}; pg8::MapOrderT<M / 256, 8, 1> S; S.init(G, bx);
            EpiZin E{Z, RowScaleStash{(LAS float*)(lds + RING_BYTES + 1024), rowinfo2, -1, -1, -1, -1, false}};
            pg8::gemm_phase<EpiZin, pg8::MapOrderT<M / 256, 8, 1>, true, true>(lds, g, S, E); PSAVE(3); }
    }
    SEAM_L(3);
    if (IN(4)) {
        const int c0 = 2 * tid;
        f32x2 wA[CA];
#pragma unroll
        for (int k = 0; k < CA; ++k) wA[k] = *(const f32x2*)(args.in[7] + (size_t)k * D + c0);
        const f32x2 cbias = *(const f32x2*)(args.in[8] + c0), lng = *(const f32x2*)(args.in[9] + c0), lnb = *(const f32x2*)(args.in[10] + c0);
        const int co = (tid & 127) * 8, tq = tid >> 7;
        f32x4 wB[3][2];
#pragma unroll
        for (int k = 0; k < 3; ++k) { wB[k][0] = *(const f32x4*)(args.in[12] + (size_t)k * D + co); wB[k][1] = *(const f32x4*)(args.in[12] + (size_t)k * D + co + 4); }

        LAS unsigned* tile32 = (LAS unsigned*)lds;
        LAS f32x2* P = (LAS f32x2*)(lds + RING_BYTES + 1024);
        LAS f32x2* Sx = (LAS f32x2*)(lds + RING_BYTES + 2048);
        LAS float* Pm = (LAS float*)(lds + RING_BYTES + 2304);
        LAS float* Sm = (LAS float*)(lds + RING_BYTES + 2816);
        constexpr int CHUNK = 128, NBLK = CHUNK / 16;
        const int pj = tid >> 7, pch = tid & 127;
        for (int chunk = vcu; chunk < M / CHUNK; chunk += G) {
            const int tg0 = chunk * CHUNK; const bool seq_start = (tg0 & (SEQ - 1)) == 0;
            const size_t zl = (size_t)(tg0 >> 12) * ZX;
            const bf16* Z0 = Z + zl; const bf16* Z1 = Z + ZK + zl; bf16* Z2 = Z + 2 * ZK + zl;
#pragma unroll
            for (int b = -2; b <= 0; ++b)
#pragma unroll
                for (int q = 0; q < 4; ++q) { const int j = pj + 4 * q;
                    v4u v = (v4u){0u, 0u, 0u, 0u}; if (!(b < 0 && seq_start)) v = *(const GAS v4u*)(Z0 + (size_t)(tg0 + 16 * b + j) * D + pch * 8);
                    *(LAS v4u*)(lds + (b + 2) * 32768 + j * 2048 + pch * 16) = v; }
            __syncthreads();
            for (int s = 0; s < NBLK; ++s) {
                const int t0 = tg0 + 16 * s;
                v4u pf[4];
                if (s + 1 < NBLK) {
#pragma unroll
                    for (int q = 0; q < 4; ++q) pf[q] = *(const GAS v4u*)(Z0 + (size_t)(t0 + 16 + pj + 4 * q) * D + pch * 8);
                }
                f32x2 a[16];
#pragma unroll
                for (int tt = 0; tt < 16; ++tt) a[tt] = cbias;
                const int rbase = 16 * s + 2;
#pragma unroll
                for (int r = 0; r < 46; ++r) {
                    const unsigned xv = tile32[((rbase + r) & 63) * 512 + tid]; const f32x2 xf = (f32x2){bflo(xv), bfhi(xv)};
#pragma unroll
                    for (int tt = 0; tt < 16; ++tt) { const int k = r - tt; if (k >= 0 && k < CA) a[tt] = xf * wA[k] + a[tt]; }
                }
                float v[32];
#pragma unroll
                for (int tt = 0; tt < 16; ++tt) { v[2 * tt] = a[tt].x + a[tt].y; v[2 * tt + 1] = a[tt].x * a[tt].x + a[tt].y * a[tt].y; }
#pragma unroll
                for (int i = 0; i < 16; ++i) { auto r = __builtin_amdgcn_permlane16_swap(__builtin_bit_cast(unsigned, v[i]), __builtin_bit_cast(unsigned, v[i + 16]), false, false);
                    v[i] = __builtin_bit_cast(float, (unsigned)r[0]) + __builtin_bit_cast(float, (unsigned)r[1]); }
#define P4_DPP(x, ctrl) __builtin_bit_cast(float, __builtin_amdgcn_update_dpp(0, __builtin_bit_cast(int, x), ctrl, 0xF, 0xF, false))
                {   const bool u3 = (lane & 8) != 0, u2 = (lane & 4) != 0, u1 = (lane & 2) != 0, u0 = (lane & 1) != 0;
#pragma unroll
                    for (int i = 0; i < 8; ++i) { const float lo_ = v[i], hi_ = v[i + 8]; const float send = u3 ? lo_ : hi_, keep = u3 ? hi_ : lo_; v[i] = keep + P4_DPP(send, 0x140); }
#pragma unroll
                    for (int i = 0; i < 4; ++i) { const float lo_ = v[i], hi_ = v[i + 4]; const float send = u2 ? lo_ : hi_, keep = u2 ? hi_ : lo_; v[i] = keep + P4_DPP(send, 0x141); }
#pragma unroll
                    for (int i = 0; i < 2; ++i) { const float lo_ = v[i], hi_ = v[i + 2]; const float send = u1 ? lo_ : hi_, keep = u1 ? hi_ : lo_; v[i] = keep + P4_DPP(send, 0x1B); }
                    {   const float lo_ = v[0], hi_ = v[1]; const float send = u0 ? lo_ : hi_, keep = u0 ? hi_ : lo_; v[0] = keep + P4_DPP(send, 0xB1); } }
                {   auto r = __builtin_amdgcn_permlane32_swap(__builtin_bit_cast(unsigned, v[0]), __builtin_bit_cast(unsigned, v[0]), false, false);
                    v[0] = __builtin_bit_cast(float, (unsigned)r[0]) + __builtin_bit_cast(float, (unsigned)r[1]); }
                if (lane < 32) ((LAS float*)P)[wave * 32 + lane] = v[0];
                if (s + 1 < NBLK) {
#pragma unroll
                    for (int q = 0; q < 4; ++q) *(LAS v4u*)(lds + ((s + 3) & 3) * 32768 + (pj + 4 * q) * 2048 + pch * 16) = pf[q];
                }
                v4u cxv[6], bbv[4];
#pragma unroll
                for (int r = 0; r < 6; ++r) { const int rr = 4 * tq - 2 + r;
                    cxv[r] = (v4u){0u, 0u, 0u, 0u}; if (!(s == 0 && seq_start && rr < 0)) cxv[r] = *(const GAS v4u*)(Z1 + (size_t)(t0 + rr) * D + co); }
#pragma unroll
                for (int r = 0; r < 4; ++r) bbv[r] = *(const GAS v4u*)(Z2 + (size_t)(t0 + 4 * tq + r) * D + co);
                __syncthreads();
                if (tid < 16) { float sm = 0.f, q = 0.f;
#pragma unroll
                    for (int w = 0; w < 8; ++w) { const f32x2 p = P[w * 16 + tid]; sm += p.x; q += p.y; }
                    const float mean = sm * (1.0f / D), var = fmaxf(q * (1.0f / D) - mean * mean, 0.f); Sx[tid] = (f32x2){mean, rsqrtf(var + EPS)}; }
                __syncthreads();
                float vm[16];
#pragma unroll
                for (int tt = 0; tt < 16; ++tt) {
                    const f32x2 st = Sx[tt]; const f32x2 y = (a[tt] - st.x) * st.y * lng + lnb;
                    a[tt] = (f32x2){y.x * sigmoidf_(y.x), y.y * sigmoidf_(y.y)};
                    vm[tt] = fmaxf(fabsf(a[tt].x), fabsf(a[tt].y));
                }
                {   const bool u3 = (lane & 8) != 0, u2 = (lane & 4) != 0, u1 = (lane & 2) != 0, u0 = (lane & 1) != 0;
#pragma unroll
                    for (int i = 0; i < 8; ++i) { const float lo_ = vm[i], hi_ = vm[i + 8]; const float send = u3 ? lo_ : hi_, keep = u3 ? hi_ : lo_; vm[i] = fmaxf(keep, P4_DPP(send, 0x140)); }
#pragma unroll
                    for (int i = 0; i < 4; ++i) { const float lo_ = vm[i], hi_ = vm[i + 4]; const float send = u2 ? lo_ : hi_, keep = u2 ? hi_ : lo_; vm[i] = fmaxf(keep, P4_DPP(send, 0x141)); }
#pragma unroll
                    for (int i = 0; i < 2; ++i) { const float lo_ = vm[i], hi_ = vm[i + 2]; const float send = u1 ? lo_ : hi_, keep = u1 ? hi_ : lo_; vm[i] = fmaxf(keep, P4_DPP(send, 0x1B)); }
                    {   const float lo_ = vm[0], hi_ = vm[1]; const float send = u0 ? lo_ : hi_, keep = u0 ? hi_ : lo_; vm[0] = fmaxf(keep, P4_DPP(send, 0xB1)); } }
                vm[0] = fq_max(vm[0]);
                if (lane < 16) Pm[wave * 16 + lane] = vm[0];
#undef P4_DPP
                __syncthreads();
                if (tid < 16) { float mx = Pm[tid];
#pragma unroll
                    for (int w = 1; w < 8; ++w) mx = fmaxf(mx, Pm[w * 16 + tid]);
                    mx = fmaxf(mx, 1e-20f); Sm[tid] = 127.0f / mx; rsA[t0 + tid] = mx * (1.0f / 127.0f); }
                __syncthreads();
#pragma unroll
                for (int tt = 0; tt < 16; ++tt) {
                    const float inv = Sm[tt];
                    unsigned q = 0u;
                    q = __builtin_amdgcn_cvt_pk_u8_f32(__builtin_rintf(a[tt].x * inv) + 128.0f, 0, q);
                    q = __builtin_amdgcn_cvt_pk_u8_f32(__builtin_rintf(a[tt].y * inv) + 128.0f, 1, q);
                    *(GAS unsigned short*)((GAS unsigned char*)RA + (size_t)(t0 + tt) * (2 * D) + c0) = (unsigned short)(q ^ 0x8080u);
                }
                if (!args.skip_b) {
                    f32x4 x0[6], x1[6];
#pragma unroll
                    for (int r = 0; r < 6; ++r) unpack8(cxv[r], x0[r], x1[r]);
#pragma unroll
                    for (int j = 0; j < 4; ++j) { f32x4 b0, b1; unpack8(bbv[j], b0, b1);
                        const f32x4 v0 = (wB[0][0] * x0[j] + wB[1][0] * x0[j + 1] + wB[2][0] * x0[j + 2]) * b0, v1 = (wB[0][1] * x1[j] + wB[1][1] * x1[j + 1] + wB[2][1] * x1[j + 2]) * b1;
                        *(GAS v4u*)(Z2 + (size_t)(t0 + 4 * tq + j) * D + co) = pack8(v0, v1); }
                }
            }
            __syncthreads();
        }
    }
    SEAM_L(4);
    if (IN(5)) {
        pg8::Gemm g{RA, WA, Z + 2 * ZK, WB, M, D, D, 0, ZX * 2}; pg8::DualOrderT<M / 256, D / 256> S; S.s.init(G, bx);
        EpiMix E{Z + 3 * ZS, Z + 4 * ZS, Z, rsA, sBa};
        pg8::gemm_phase<EpiMix, pg8::DualOrderT<M / 256, D / 256>, PG8_ALIGN, PG8_SP2>(lds, g, S, E); PSAVE(5);
    }
    SEAM_L(5);
    if (IN(6)) {
        pg8::Gemm g{Z, WO, nullptr, nullptr, M, D, D, ZX * 2, 0}; pg8::StaticOrderT<M / 256, D / 256> S; S.init(G, bx);
#if MK_Q2
        typedef EpiResidQT<0, HBX * 2> EpiResidQ6;
        EpiResidQ6 E{HB1, RA, QA, rowinfo3, (unsigned long long*)(ws + WS_XBUF2), (unsigned*)(ctl + CW_PANEL2), lds, 1.0f};
        pg8::gemm_phase<EpiResidQ6, pg8::StaticOrderT<M / 256, D / 256>, PG8_ALIGN, PG8_SP2>(lds, g, S, E); PSAVE(6);
#else
        EpiResid<true> E{nullptr, HB1, RA, ssp3, 1.0f};
        pg8::gemm_phase<EpiResid<true>, pg8::StaticOrderT<M / 256, D / 256>, PG8_ALIGN, PG8_SP2>(lds, g, S, E); PSAVE(6);
#endif
    }
    SEAM_L(6);
    if (IN(7)) {
#if MK_Q2
        pg8::Gemm g{(const bf16*)QA, (const bf16*)W2q, nullptr, nullptr, M, 2 * FF, D / 2}; pg8::StaticOrderT<M / 256, 2 * FF / 256> S; S.init(G, bx);
        EpiSwigluQ E{HID, sB2, RowScaleStash{(LAS float*)(lds + RING_BYTES + 1024), rowinfo3, -1, -1, -1, -1}};
        pg8::gemm_phase<EpiSwigluQ, pg8::StaticOrderT<M / 256, 2 * FF / 256>, true, true>(lds, g, S, E); PSAVE(7);
#else
        pg8::Gemm g{RA, W2, nullptr, nullptr, M, 2 * FF, D}; pg8::StaticOrderT<M / 256, 2 * FF / 256> S; S.init(G, bx);
        EpiSwiglu E{HID, RstdStash{(LAS float*)(lds + RING_BYTES + 1024), ssp3, -1, -1, -1, -1}};
        pg8::gemm_phase<EpiSwiglu, pg8::StaticOrderT<M / 256, 2 * FF / 256>, true, true>(lds, g, S, E); PSAVE(7);
#endif
    }
    SEAM_L(7);
    if (IN(8)) {
        pg8::Gemm g{HID, WD2, nullptr, nullptr, M, D, FF, HX * 2, 0}; pg8::StaticOrderT<M / 256, D / 256> S; S.init(G, bx);
        float padd = 0.f;
#ifdef MK_PROBE
        {   const int ka = MK_PROBE_A;
            if (ka != 21) padd = 0.02f * ((ka < 16) ? (float)(long long)(stamps[ka + 1] - stamps[ka]) * 0.01f : (float)(long long)(stamps[8] - stamps[0]) * 0.001f); }
#endif
        EpiFinal E{RA, out, args.in[19], (float*)(ws + WS_XBUF), (unsigned*)(ctl + CW_PANEL), lds, 0.5f, padd};
        pg8::gemm_phase<EpiFinal, pg8::StaticOrderT<M / 256, D / 256>, PG8_ALIGN, PG8_SP2>(lds, g, S, E); PSAVE(8);
#ifdef MK_PROBE
        if (MK_PROBE_A == 21 && bx == 0 && tid == 0) { VM_WAIT(); out[0] += 0.02f * 0.001f * (float)(long long)(__builtin_amdgcn_s_memrealtime() - stamps[0]); }
#endif
    }
#undef IN
#undef SEAM
#undef SEAM_L
}

extern "C" void kernel_launch(void* const* d_in, const int* in_sizes, int n_in, void* d_out, int out_size, void* d_ws, size_t ws_size, hipStream_t stream) {
    static int grid = 0;
    if (grid == 0) {
        if (n_in != 20 || in_sizes[0] != M * D || out_size != M * D || ws_size < WS_END) {
            fprintf(stderr, "kernel_launch: built for 20 inputs, x/out of %d floats, >= %zu bytes of workspace; got n_in %d, in0 %d, out %d, ws %zu; nothing launched\n", M * D, (size_t)WS_END, n_in, n_in > 0 ? in_sizes[0] : -1, out_size, ws_size);
            grid = -1; return; }
        int dev = 0, cus = 0, per_cu = 0;
        if (hipGetDevice(&dev) != hipSuccess || hipDeviceGetAttribute(&cus, hipDeviceAttributeMultiprocessorCount, dev) != hipSuccess) { fprintf(stderr, "kernel_launch: device query failed\n"); grid = -1; return; }
        if (hipFuncSetAttribute((const void*)mk_fwd, hipFuncAttributeMaxDynamicSharedMemorySize, LDS_BYTES) != hipSuccess) { fprintf(stderr, "kernel_launch: hipFuncSetAttribute failed\n"); grid = -1; return; }
        if (hipOccupancyMaxActiveBlocksPerMultiprocessor(&per_cu, (const void*)mk_fwd, NWAVES * 64, LDS_BYTES) != hipSuccess || per_cu < 1) { fprintf(stderr, "kernel_launch: occupancy query says %d blocks per CU\n", per_cu); per_cu = 1; }
        (void)hipGetLastError();
        grid = cus > 256 ? 256 : cus;
        grid -= grid % 32;
        if (grid != 256) fprintf(stderr, "kernel_launch: note: %d CUs -> grid %d (tuned for 256)\n", cus, grid);
        if (grid < 32) { grid = -1; return; }
    }
    if (grid < 0) return;
    if (hipMemsetAsync((char*)d_ws + WS_CTL, 0, CTL_ZERO_BYTES, stream) != hipSuccess) { fprintf(stderr, "kernel_launch: memset failed\n"); return; }
    Args a{};
    for (int i = 0; i < 20; ++i) a.in[i] = (const float*)d_in[i];
    a.out = (float*)d_out; a.ws = (unsigned char*)d_ws;
    if (MK_REP_PHASE >= 0) {
        a.ph_lo = 0; a.ph_hi = MK_REP_PHASE + 1; a.use_bar = 1; a.skip_b = (MK_REP_PHASE == 4);
        hipLaunchKernelGGL(mk_fwd, dim3(grid), dim3(NWAVES * 64), LDS_BYTES, stream, a);
        (void)hipMemsetAsync((char*)d_ws + WS_CTL, 0, CTL_ZERO_BYTES, stream);
        a.ph_lo = MK_REP_PHASE; a.ph_hi = N_PHASES; a.skip_b = 0;
        hipLaunchKernelGGL(mk_fwd, dim3(grid), dim3(NWAVES * 64), LDS_BYTES, stream, a);
    } else if (MK_N_LAUNCHES == 1) {
        a.ph_lo = 0; a.ph_hi = N_PHASES; a.use_bar = 1;
        hipLaunchKernelGGL(mk_fwd, dim3(grid), dim3(NWAVES * 64), LDS_BYTES, stream, a);
    } else {
        for (int p = 0; p < N_PHASES; ++p) { a.ph_lo = p; a.ph_hi = p + 1; a.use_bar = 0;
            hipLaunchKernelGGL(mk_fwd, dim3(grid), dim3(NWAVES * 64), LDS_BYTES, stream, a); }
    }
    const hipError_t le = hipPeekAtLastError();
    if (le != hipSuccess) fprintf(stderr, "kernel_launch: launch failed: %s\n", hipGetErrorName(le));
}
```

```cpp
#include <hip/hip_runtime.h>
#include <cstdio>
#include <cstdint>
#include <type_traits>

#ifndef MK_N_LAUNCHES
#define MK_N_LAUNCHES 1
#endif
#define MK_KREP 1
#define MK_Q2 1
#define MK_REP_PHASE -1
#define MK_PROBE_A 3
#define MK_PROBE_B 0

namespace pg8 {
#define PG8_LAS __attribute__((address_space(3)))
typedef unsigned short bf16_t;
typedef short bf16x8 __attribute__((ext_vector_type(8)));
typedef float f32x4 __attribute__((ext_vector_type(4)));
typedef unsigned u32x4 __attribute__((ext_vector_type(4)));
typedef int i32x4 __attribute__((ext_vector_type(4)));
__device__ __forceinline__ f32x4 mma16(const bf16x8& b, const bf16x8& a, const f32x4& c) { return __builtin_amdgcn_mfma_f32_16x16x32_bf16(b, a, c, 0, 0, 0); }
__device__ __forceinline__ i32x4 mma16(const bf16x8& b, const bf16x8& a, const i32x4& c) { return __builtin_amdgcn_mfma_i32_16x16x64_i8(__builtin_bit_cast(i32x4, b), __builtin_bit_cast(i32x4, a), c, 0, 0, 0); }
constexpr int BM = 256, BK = 64, HALF = 128, HTB = HALF * BK * 2  , STAGE_BYTES = 8 * HTB, NXCD = 8, WGM = 8;

__host__ __device__ __forceinline__ int lds_byte(int r, int c) { const int st = (r >> 4) * 2 + (c >> 5), rr = r & 15, cc = c & 31, ob = rr * 64 + cc * 2; return st * 1024 + (ob ^ (((ob >> 9) & 1) << 5)); }
__host__ __device__ __forceinline__ void stage_rc(int b, int& R, int& C) { const int st = b / 1024, sb = b % 1024, swz = sb ^ (((sb >> 9) & 1) << 5); R = (st >> 1) * 16 + swz / 64; C = (st & 1) * 32 + (swz % 64) / 2; }
__host__ __device__ __forceinline__ int perm32(int rho) { const int n = rho >> 4, i = rho & 15; return 8 * (i >> 2) + 4 * n + (i & 3); }

struct Unit { int pm, pn, sel; };
struct Gemm { const bf16_t* A; const bf16_t* Bt; const bf16_t* A2; const bf16_t* Bt2; int M, N, K; size_t laneA, laneA2; };

template <int NM, int NN> struct StaticOrderT {
    static_assert(NM % WGM == 0 && (NM * NN) % NXCD == 0, "tile counts");
    static constexpr int nwg = NM * NN, q = nwg / NXCD, nig = WGM * NN;
    int G, c;
    __device__ __forceinline__ void init(int G_, int c_) { G = G_; c = c_; }
    __device__ __forceinline__ bool next(int i, Unit& u) const {
        const int L = i * G + c; if (L >= nwg) return false;
        const int wgid = (L & (NXCD - 1)) * q + (L >> 3);
        const int gid = wgid / nig, rem = wgid - gid * nig;
        u.pm = gid * WGM + (rem & (WGM - 1)); u.pn = rem >> 3; u.sel = 0; return true;
    }
};
template <int NM, int NN, int MODE> struct MapOrderT {
    StaticOrderT<NM, NN> s;
    __device__ __forceinline__ void init(int G_, int c_) { s.init(G_, c_); }
    __device__ __forceinline__ bool next(int i, Unit& u) const { if (!s.next(i, u)) return false; u.pn = MODE == 0 ? (u.pn < 8 ? u.pn : u.pn + 8) : (u.pn < 8 ? u.pn + 8 : u.pn + 16); return true; }
};
template <int NM, int NN> struct DualOrderT {
    StaticOrderT<NM, NN> s;
    __device__ bool next(int j, Unit& u) const { if (!s.next(j >> 1, u)) return false; u.sel = j & 1; return true; }
};

__device__ __forceinline__ unsigned cvt_pk_bf16(float lo, float hi) { unsigned r; asm volatile("v_cvt_pk_bf16_f32 %0, %1, %2" : "=v"(r) : "v"(lo), "v"(hi)); return r; }

template <class E, class = void> struct mixed_of { static constexpr bool value = false; };
template <class E> struct mixed_of<E, typename std::enable_if<E::MIXED>::type> { static constexpr bool value = true; };
template <class E, class = void> struct pre_of { static constexpr bool value = false; };
template <class E> struct pre_of<E, typename std::enable_if<E::PRE>::type> { static constexpr bool value = true; };
template <class Epi, class Sched, bool ALIGN_EPI = false, bool SP2 = false>
__device__ __forceinline__ void gemm_phase(PG8_LAS unsigned char* lds, const Gemm g, const Sched& S, const Epi& E) {
    const int tid = threadIdx.x, wid = __builtin_amdgcn_readfirstlane(tid >> 6), lane = tid & 63, wr = wid >> 2, wc = wid & 3, fr = lane & 15, fq = lane >> 4;
    const int K = g.K, nt = K / BK;
    unsigned voffA[2], voffB[2];
#pragma unroll
    for (int i = 0; i < 2; ++i) { int R, C; stage_rc(tid * 16 + i * 8192, R, C); const int Rb = Epi::PERM ? ((R & ~31) + perm32(R & 31)) : R;
        voffA[i] = (unsigned)(R * K + C) * 2u; voffB[i] = (unsigned)(Rb * K + C) * 2u; }
    const size_t kstep = (size_t)(BK * 2);
    const size_t hstep = (size_t)HALF * K * 2;
    const size_t tstep = 2 * hstep;
    const unsigned ldsw = (unsigned)wid * 1024u;
    const int aoff = lds_byte(wr * 64 + fr, fq * 8), boff = lds_byte(wc * 32 + fr, fq * 8);
#define PG8_SA(b, h) (((b) * 2 + (h)) * HTB)
#define PG8_SB(b, h) ((4 + (b) * 2 + (h)) * HTB)
#define PG8_STAGE(bufoff, gbase, voff) do { const __amdgpu_buffer_rsrc_t r_ = __builtin_amdgcn_make_buffer_rsrc((void*)(gbase), 0, 0x7fffffff, 0x00020000); \
        _Pragma("unroll") for (int _i = 0; _i < 2; ++_i) \
        __builtin_amdgcn_raw_ptr_buffer_load_lds(r_, (PG8_LAS void*)(lds + (bufoff) + ldsw + _i * 8192), 16, (int)(voff)[_i], 0, 0, 0); } while (0)
#define PG8_LDA(dst, b, h) do { _Pragma("unroll") for (int m = 0; m < 4; ++m) _Pragma("unroll") for (int k = 0; k < 2; ++k) dst[m][k] = *(const PG8_LAS bf16x8*)(lds + PG8_SA(b, h) + aoff + m * 2048 + k * 1024); } while (0)
#define PG8_LDB(dst, b, h) do { _Pragma("unroll") for (int n = 0; n < 2; ++n) _Pragma("unroll") for (int k = 0; k < 2; ++k) dst[n][k] = *(const PG8_LAS bf16x8*)(lds + PG8_SB(b, h) + boff + n * 2048 + k * 1024); } while (0)
#define PG8_MMA(ai, bj, At, Bt) do { __builtin_amdgcn_s_setprio(1); _Pragma("unroll") for (int m = 0; m < 4; ++m) _Pragma("unroll") for (int n = 0; n < 2; ++n) _Pragma("unroll") for (int k = 0; k < 2; ++k) \
        acc[ai][bj][m][n] = mma16(Bt[n][k], At[m][k], acc[ai][bj][m][n]); __builtin_amdgcn_s_setprio(0); } while (0)
#define PG8_MMA_I8(ai, bj, At, Bt) do { __builtin_amdgcn_s_setprio(1); _Pragma("unroll") for (int m = 0; m < 4; ++m) _Pragma("unroll") for (int n = 0; n < 2; ++n) _Pragma("unroll") for (int k = 0; k < 2; ++k) \
        acc[ai][bj][m][n] = __builtin_bit_cast(acc_t, __builtin_amdgcn_mfma_i32_16x16x64_i8(__builtin_bit_cast(i32x4, Bt[n][k]), __builtin_bit_cast(i32x4, At[m][k]), __builtin_bit_cast(i32x4, acc[ai][bj][m][n]), 0, 0, 0)); \
        __builtin_amdgcn_s_setprio(0); } while (0)
#define PG8_ADDR(ntu) const bool last = (t == (ntu) - 2); const char* a1 = cA + (size_t)(t + 1) * kstep; \
        const char* a2 = last ? nA : cA + (size_t)(t + 2) * kstep; const char* b2 = last ? nB : cB + (size_t)(t + 2) * kstep; const char* a3 = a2 + kstep; const char* b3 = b2 + kstep
#define PG8_ITER(MMAM) do { \
        PG8_LDB(B0, 0, 0); PG8_LDB(B1, 0, 1); PG8_SCHED; PG8_LDA(At, 0, 0); PG8_STAGE(PG8_SA(1, 1), a1 + hstep, voffA); \
        PG8_WAIT_V(8); PG8_WAIT_L(0); PG8_BAR; MMAM(0, 0, At, B0); MMAM(0, 1, At, B1); PG8_BAR; PG8_SCHED; \
        PG8_LDA(At, 0, 1); PG8_STAGE(PG8_SB(0, 0), b2, voffB); PG8_STAGE(PG8_SB(0, 1), b2 + hstep, voffB); PG8_STAGE(PG8_SA(0, 0), a2, voffA); \
        PG8_WAIT_V(8); PG8_WAIT_L(0); PG8_BAR; MMAM(1, 0, At, B0); MMAM(1, 1, At, B1); PG8_BAR; PG8_SCHED; \
        PG8_LDB(B0, 1, 0); PG8_LDB(B1, 1, 1); PG8_SCHED; PG8_LDA(At, 1, 0); PG8_STAGE(PG8_SA(0, 1), a2 + hstep, voffA); \
        PG8_WAIT_V(8); PG8_WAIT_L(0); PG8_BAR; MMAM(0, 0, At, B0); MMAM(0, 1, At, B1); PG8_BAR; PG8_SCHED; \
        PG8_LDA(At, 1, 1); PG8_STAGE(PG8_SB(1, 0), b3, voffB); PG8_STAGE(PG8_SB(1, 1), b3 + hstep, voffB); PG8_STAGE(PG8_SA(1, 0), a3, voffA); \
        PG8_WAIT_V(8); PG8_WAIT_L(0); PG8_BAR; MMAM(1, 0, At, B0); MMAM(1, 1, At, B1); PG8_BAR; PG8_SCHED; } while (0)
#define PG8_ITERR(MMAM, vo2, hs2, vb2, hb2) do { \
        PG8_LDB(B0, 0, 0); PG8_LDB(B1, 0, 1); PG8_SCHED; PG8_LDA(At, 0, 0); PG8_STAGE(PG8_SA(1, 1), a1 + hstep, voffA); \
        PG8_WAIT_V(8); PG8_WAIT_L(0); PG8_BAR; MMAM(0, 0, At, B0); MMAM(0, 1, At, B1); PG8_BAR; PG8_SCHED; \
        PG8_LDA(At, 0, 1); PG8_STAGE(PG8_SB(0, 0), b2, vb2); PG8_STAGE(PG8_SB(0, 1), b2 + (hb2), vb2); PG8_STAGE(PG8_SA(0, 0), a2, vo2); \
        PG8_WAIT_V(8); PG8_WAIT_L(0); PG8_BAR; MMAM(1, 0, At, B0); MMAM(1, 1, At, B1); PG8_BAR; PG8_SCHED; \
        PG8_LDB(B0, 1, 0); PG8_LDB(B1, 1, 1); PG8_SCHED; PG8_LDA(At, 1, 0); PG8_STAGE(PG8_SA(0, 1), a2 + (hs2), vo2); \
        PG8_WAIT_V(8); PG8_WAIT_L(0); PG8_BAR; MMAM(0, 0, At, B0); MMAM(0, 1, At, B1); PG8_BAR; PG8_SCHED; \
        PG8_LDA(At, 1, 1); PG8_STAGE(PG8_SB(1, 0), b3, vb2); PG8_STAGE(PG8_SB(1, 1), b3 + (hb2), vb2); PG8_STAGE(PG8_SA(1, 0), a3, vo2); \
        PG8_WAIT_V(8); PG8_WAIT_L(0); PG8_BAR; MMAM(1, 0, At, B0); MMAM(1, 1, At, B1); PG8_BAR; PG8_SCHED; } while (0)
#define PG8_RDP(dst, slot) do { _Pragma("unroll") for (int m = 0; m < 4; ++m) dst[m] = *(const PG8_LAS u32x4*)(lds + (slot) + poff + m * 2048); } while (0)
#define PG8_ADDP(ai, J, src) do { if ((wc >> 1) == ((J) & 1)) { _Pragma("unroll") for (int m = 0; m < 4; ++m) { const u32x4 w_ = src[m]; \
        const f32x4 lo_ = (f32x4){__builtin_bit_cast(float, w_.x << 16), __builtin_bit_cast(float, w_.x & 0xffff0000u), __builtin_bit_cast(float, w_.y << 16), __builtin_bit_cast(float, w_.y & 0xffff0000u)}; \
        const f32x4 hi_ = (f32x4){__builtin_bit_cast(float, w_.z << 16), __builtin_bit_cast(float, w_.z & 0xffff0000u), __builtin_bit_cast(float, w_.w << 16), __builtin_bit_cast(float, w_.w & 0xffff0000u)}; \
        acc[ai][(J) >> 1][m][0] += lo_ * binv; acc[ai][(J) >> 1][m][1] += hi_ * binv; } } } while (0)
#define PG8_ITERP() do { \
        PG8_RDP(PA, PG8_SA(0, 0)); PG8_RDP(PB0, PG8_SB(0, 0)); PG8_RDP(PB1, PG8_SB(0, 1)); PG8_STAGE(PG8_SA(1, 1), pA + kstep + hstepP, voffP); \
        PG8_WAIT_V(8); PG8_WAIT_L(0); PG8_BAR; PG8_ADDP(0, 0, PA); PG8_ADDP(0, 2, PB0); PG8_ADDP(1, 2, PB1); PG8_BAR; PG8_SCHED; \
        PG8_RDP(PA, PG8_SA(0, 1)); PG8_STAGE(PG8_SB(0, 0), nB, voffB); PG8_STAGE(PG8_SB(0, 1), nB + hstep, voffB); PG8_STAGE(PG8_SA(0, 0), nA, voffA); \
        PG8_WAIT_V(8); PG8_WAIT_L(0); PG8_BAR; PG8_ADDP(1, 0, PA); PG8_BAR; PG8_SCHED; \
        PG8_RDP(PA, PG8_SA(1, 0)); PG8_RDP(PB0, PG8_SB(1, 0)); PG8_RDP(PB1, PG8_SB(1, 1)); PG8_STAGE(PG8_SA(0, 1), nA + hstep, voffA); \
        PG8_WAIT_V(8); PG8_WAIT_L(0); PG8_BAR; PG8_ADDP(0, 1, PA); PG8_ADDP(0, 3, PB0); PG8_ADDP(1, 3, PB1); PG8_BAR; PG8_SCHED; \
        PG8_RDP(PA, PG8_SA(1, 1)); PG8_STAGE(PG8_SB(1, 0), nB + kstep, voffB); PG8_STAGE(PG8_SB(1, 1), nB + kstep + hstep, voffB); PG8_STAGE(PG8_SA(1, 0), nA + kstep, voffA); \
        PG8_WAIT_V(8); PG8_WAIT_L(0); PG8_BAR; PG8_ADDP(1, 1, PA); PG8_BAR; PG8_SCHED; } while (0)
#define PG8_RAF(ai, BJ, slot) do { f32x4 f_[4][2]; _Pragma("unroll") for (int m = 0; m < 4; ++m) { f_[m][0] = *(const PG8_LAS f32x4*)(lds + (slot) + pofa + m * 2048); f_[m][1] = *(const PG8_LAS f32x4*)(lds + (slot) + pofb + m * 2048); } \
        PG8_WAIT_L(0); _Pragma("unroll") for (int m = 0; m < 4; ++m) { acc[ai][BJ][m][0] += f_[m][0] * binv; acc[ai][BJ][m][1] += f_[m][1] * binv; } } while (0)
#define PG8_ITERPF(BJ, LATE, A2, A3, B2, B3, VOA, HSA, VOB, HSB) do { \
        if (wc == 0) PG8_RAF(0, BJ, PG8_SA(0, 0)); if (wc == 2) { PG8_RAF(0, BJ, PG8_SB(0, 0)); PG8_RAF(1, BJ, PG8_SB(0, 1)); } PG8_STAGE(PG8_SA(1, 1), (LATE) + hstepF, voffF); \
        PG8_WAIT_V(8); PG8_WAIT_L(0); PG8_BAR; PG8_BAR; PG8_SCHED; \
        if (wc == 0) PG8_RAF(1, BJ, PG8_SA(0, 1)); PG8_STAGE(PG8_SB(0, 0), B2, VOB); PG8_STAGE(PG8_SB(0, 1), (B2) + (HSB), VOB); PG8_STAGE(PG8_SA(0, 0), A2, VOA); \
        PG8_WAIT_V(8); PG8_WAIT_L(0); PG8_BAR; PG8_BAR; PG8_SCHED; \
        if (wc == 1) PG8_RAF(0, BJ, PG8_SA(1, 0)); if (wc == 3) { PG8_RAF(0, BJ, PG8_SB(1, 0)); PG8_RAF(1, BJ, PG8_SB(1, 1)); } PG8_STAGE(PG8_SA(0, 1), (A2) + (HSA), VOA); \
        PG8_WAIT_V(8); PG8_WAIT_L(0); PG8_BAR; PG8_BAR; PG8_SCHED; \
        if (wc == 1) PG8_RAF(1, BJ, PG8_SA(1, 1)); PG8_STAGE(PG8_SB(1, 0), B3, VOB); PG8_STAGE(PG8_SB(1, 1), (B3) + (HSB), VOB); PG8_STAGE(PG8_SA(1, 0), A3, VOA); \
        PG8_WAIT_V(8); PG8_WAIT_L(0); PG8_BAR; PG8_BAR; PG8_SCHED; } while (0)
#define PG8_WAIT_V(n) asm volatile("s_waitcnt vmcnt(" #n ")" ::: "memory")
#define PG8_WAIT_L(n) asm volatile("s_waitcnt lgkmcnt(" #n ")" ::: "memory")
#define PG8_BAR __builtin_amdgcn_s_barrier()
#define PG8_SCHED __builtin_amdgcn_sched_barrier(0)
#define PG8_ZERO(ai) do { _Pragma("unroll") for (int b_ = 0; b_ < 2; ++b_) _Pragma("unroll") for (int m_ = 0; m_ < 4; ++m_) _Pragma("unroll") for (int n_ = 0; n_ < 2; ++n_) acc[ai][b_][m_][n_] = acc_t{}; } while (0)
#define PG8_ABASE(u) ((const char*)((u).sel ? g.A2 : g.A) + (size_t)(u).pm * tstep + (size_t)((u).pm >> 4) * ((u).sel ? g.laneA2 : g.laneA))
#define PG8_BBASE(u) ((const char*)((u).sel ? g.Bt2 : g.Bt) + (size_t)(u).pn * tstep)
    Unit cur, nxt; int ui = 0;
    if (!S.next(0, cur)) return;
#ifdef MK_PROBE
    PG8_LAS unsigned long long* pk = (PG8_LAS unsigned long long*)(lds + 131072 + 64);
#endif
    typedef typename Epi::acc_t acc_t;
    acc_t acc[2][2][4][2];
#pragma unroll
    for (int a = 0; a < 2; ++a)
#pragma unroll
        for (int b = 0; b < 2; ++b)
#pragma unroll
            for (int m = 0; m < 4; ++m)
#pragma unroll
                for (int n = 0; n < 2; ++n) acc[a][b][m][n] = acc_t{};
    bf16x8 At[4][2], B0[2][2], B1[2][2];
    const char* cA = PG8_ABASE(cur); const char* cB = PG8_BBASE(cur);
    bool pending = false; Unit prev = cur;
    if constexpr (SP2) {
        PG8_STAGE(PG8_SB(0, 0), cB, voffB); PG8_STAGE(PG8_SB(0, 1), cB + hstep, voffB); PG8_SCHED; PG8_STAGE(PG8_SA(0, 0), cA, voffA); PG8_STAGE(PG8_SA(0, 1), cA + hstep, voffA); PG8_SCHED;
        if constexpr (Epi::STASH) E.init(S, wr, fr, fq);
        if (wr == 1) PG8_BAR;
        PG8_WAIT_V(2); PG8_BAR;
        PG8_STAGE(PG8_SB(1, 0), cB + kstep, voffB); PG8_STAGE(PG8_SA(1, 0), cA + kstep, voffA); PG8_STAGE(PG8_SB(1, 1), cB + hstep + kstep, voffB);
        PG8_WAIT_V(6); PG8_BAR;
    } else {
        PG8_STAGE(PG8_SB(0, 0), cB, voffB); PG8_STAGE(PG8_SA(0, 0), cA, voffA); PG8_STAGE(PG8_SB(0, 1), cB + hstep, voffB); PG8_STAGE(PG8_SA(0, 1), cA + hstep, voffA);
        if constexpr (Epi::STASH) E.init(S, wr, fr, fq);
        if (wr == 1) PG8_BAR;
        PG8_WAIT_V(4); PG8_BAR;
        PG8_STAGE(PG8_SB(1, 0), cB + kstep, voffB); PG8_STAGE(PG8_SA(1, 0), cA + kstep, voffA); PG8_STAGE(PG8_SB(1, 1), cB + hstep + kstep, voffB);
        PG8_WAIT_V(6); PG8_BAR;
    }
    if constexpr (mixed_of<Epi>::value) {
        static_assert(!mixed_of<Epi>::value || (SP2 && ALIGN_EPI && Epi::DUAL && !Epi::SPLIT), "mixed dual GEMM: aligned SP2 loop");
        for (;;) {
            {   S.next(ui + 1, nxt);
                const char* nA = PG8_ABASE(nxt); const char* nB = PG8_BBASE(nxt);
                for (int t = 0; t < nt / 2; t += 2) { PG8_ADDR(nt / 2); PG8_ITER(PG8_MMA_I8); }
                if (wr == 0) PG8_BAR;
                E.mid(acc, cur, wr, wc, fr, fq);
                cur = nxt; cA = nA; cB = nB; ++ui;
                if (wr == 1) PG8_BAR; }
            {   const bool has_next = S.next(ui + 1, nxt);
                const char* nA = has_next ? PG8_ABASE(nxt) : cA; const char* nB = has_next ? PG8_BBASE(nxt) : cB;
                for (int t = 0; t < nt; t += 2) { PG8_ADDR(nt); PG8_ITER(PG8_MMA); }
                if (wr == 0) PG8_BAR;
                E(acc, cur, wr, wc, fr, fq);
                if (!has_next) break;
#pragma unroll
                for (int a = 0; a < 2; ++a)
#pragma unroll
                    for (int b = 0; b < 2; ++b)
#pragma unroll
                        for (int m = 0; m < 4; ++m)
#pragma unroll
                            for (int n = 0; n < 2; ++n) acc[a][b][m][n] = acc_t{};
                cur = nxt; cA = nA; cB = nB; ++ui;
                if (wr == 1) PG8_BAR; }
        }
    } else if constexpr (pre_of<Epi>::value) {
        static_assert(!pre_of<Epi>::value || (SP2 && ALIGN_EPI && !Epi::DUAL && !Epi::SPLIT), "streamed epilogue operand: aligned SP2 loop");
        constexpr int PLD = Epi::PRE_LD;
        const size_t hstepP = (size_t)HALF * PLD * 2;
        const float binv = E.pre_scale();
        if constexpr (Epi::PRE_F32) {
            const size_t hstepF = (size_t)HALF * PLD * 4;
            for (;;) {
                const bool has_next = S.next(ui + 1, nxt);
                const char* nA = has_next ? PG8_ABASE(nxt) : cA; const char* nB = has_next ? PG8_BBASE(nxt) : cB;
                for (int t = 0; t < nt - 2; t += 2) {
                    const char* a1 = cA + (size_t)(t + 1) * kstep; const char* a2 = cA + (size_t)(t + 2) * kstep; const char* b2 = cB + (size_t)(t + 2) * kstep; const char* a3 = a2 + kstep; const char* b3 = b2 + kstep;
                    PG8_ITERR(PG8_MMA, voffA, hstep, voffB, hstep); }
                int pm_o = cur.pm, pn_o = cur.pn; asm volatile("" : "+s"(pm_o), "+s"(pn_o));
                const char* pF = (const char*)E.pre_ptr() + ((size_t)pm_o * 256 * PLD + (size_t)pn_o * 256) * 4;
                int tid_p = tid; asm volatile("" : "+v"(tid_p));
                unsigned voffF[2];
#pragma unroll
                for (int i = 0; i < 2; ++i) { int R, C; stage_rc(tid_p * 16 + i * 8192, R, C); voffF[i] = (unsigned)(R * PLD * 4 + C * 2); }
                {   const char* a1 = cA + (size_t)(nt - 1) * kstep; const char* a2 = pF; const char* a3 = pF + 128; const char* b2 = pF + 256; const char* b3 = pF + 384;
                    PG8_ITERR(PG8_MMA, voffF, hstepF, voffF, hstepF); }
                int t_o = tid; asm volatile("" : "+v"(t_o));
                const int pofa = lds_byte(wr * 64 + (t_o & 15), ((t_o & 63) >> 4) * 16), pofb = lds_byte(wr * 64 + (t_o & 15), ((t_o & 63) >> 4) * 16 + 8);
                int wcv = wc; asm volatile("" : "+s"(wcv));
                {   const int wc = wcv;
                    PG8_ITERPF(0, pF + 128, pF + 512, pF + 640, pF + 768, pF + 896, voffF, hstepF, voffF, hstepF);
                    PG8_ITERPF(1, pF + 640, nA, nA + kstep, nB, nB + kstep, voffA, hstep, voffB, hstep); }
                if (wr == 0) PG8_BAR;
                E(acc, cur, wr, wc, fr, fq);
                if (!has_next) break;
#pragma unroll
                for (int a = 0; a < 2; ++a)
#pragma unroll
                    for (int b = 0; b < 2; ++b)
#pragma unroll
                        for (int m = 0; m < 4; ++m)
#pragma unroll
                            for (int n = 0; n < 2; ++n) acc[a][b][m][n] = acc_t{};
                cur = nxt; cA = nA; cB = nB; ++ui;
                if (wr == 1) PG8_BAR;
            }
        } else
        for (;;) {
            const bool has_next = S.next(ui + 1, nxt);
            const char* nA = has_next ? PG8_ABASE(nxt) : cA; const char* nB = has_next ? PG8_BBASE(nxt) : cB;
            const char* pA = (const char*)E.pre_ptr() + ((size_t)cur.pm * 256 * PLD + (size_t)cur.pn * 256) * 2 + (size_t)(cur.pm >> 4) * E.pre_lane();
            for (int t = 0; t < nt - 2; t += 2) {
                const char* a1 = cA + (size_t)(t + 1) * kstep; const char* a2 = cA + (size_t)(t + 2) * kstep; const char* b2 = cB + (size_t)(t + 2) * kstep; const char* a3 = a2 + kstep; const char* b3 = b2 + kstep;
                PG8_ITERR(PG8_MMA, voffA, hstep, voffB, hstep); }
            int tid_p = tid; asm volatile("" : "+v"(tid_p));
            unsigned voffP[2];
#pragma unroll
            for (int i = 0; i < 2; ++i) { int R, C; stage_rc(tid_p * 16 + i * 8192, R, C); voffP[i] = (unsigned)(R * PLD + C) * 2u; }
            {   const char* a1 = cA + (size_t)(nt - 1) * kstep; const char* a2 = pA; const char* a3 = pA + kstep; const char* b2 = pA + 2 * kstep; const char* b3 = pA + 3 * kstep;
                PG8_ITERR(PG8_MMA, voffP, hstepP, voffP, hstepP); }
            int aoff_o = aoff; asm volatile("" : "+v"(aoff_o));
            const int poff = aoff_o + (wc & 1) * 1024;
            u32x4 PA[4], PB0[4], PB1[4];
            PG8_ITERP();
            if (wr == 0) PG8_BAR;
            E(acc, cur, wr, wc, fr, fq);
            if (!has_next) break;
#pragma unroll
            for (int a = 0; a < 2; ++a)
#pragma unroll
                for (int b = 0; b < 2; ++b)
#pragma unroll
                    for (int m = 0; m < 4; ++m)
#pragma unroll
                        for (int n = 0; n < 2; ++n) acc[a][b][m][n] = acc_t{};
            cur = nxt; cA = nA; cB = nB; ++ui;
            if (wr == 1) PG8_BAR;
        }
    } else
    for (;;) {
        const bool has_next = S.next(ui + 1, nxt);
        const char* nA = has_next ? PG8_ABASE(nxt) : cA; const char* nB = has_next ? PG8_BBASE(nxt) : cB;
        for (int t = 0; t < nt; t += 2) {
            const bool last = (t == nt - 2);
            const char* a1 = cA + (size_t)(t + 1) * kstep;
            const char* a2 = last ? nA : cA + (size_t)(t + 2) * kstep; const char* b2 = last ? nB : cB + (size_t)(t + 2) * kstep;
            const char* a3 = a2 + kstep; const char* b3 = b2 + kstep;
#ifdef MK_PROBE_K
            if (blockIdx.x == 0 && tid == 0) { if (t == 2) pk[0] = __builtin_amdgcn_s_memrealtime(); if (t == nt - 2) pk[1] += __builtin_amdgcn_s_memrealtime() - pk[0]; }
#endif
            if constexpr (SP2) {
            bool did1 = false;
            if constexpr (Epi::SPLIT) { if (t == 0 && pending) {
                PG8_STAGE(PG8_SA(1, 1), a1 + hstep, voffA); PG8_SCHED;
                E.half(acc, prev, 1, wr, wc, fr, fq); PG8_ZERO(1); pending = false; PG8_SCHED;
                PG8_LDB(B0, 0, 0); PG8_LDB(B1, 0, 1); PG8_SCHED; PG8_LDA(At, 0, 0); did1 = true; } }
            if (!did1) { PG8_LDB(B0, 0, 0); PG8_LDB(B1, 0, 1); PG8_SCHED; PG8_LDA(At, 0, 0); PG8_STAGE(PG8_SA(1, 1), a1 + hstep, voffA); }
            PG8_WAIT_V(8); PG8_WAIT_L(0); PG8_BAR; PG8_MMA(0, 0, At, B0); PG8_MMA(0, 1, At, B1); PG8_BAR; PG8_SCHED;
            PG8_LDA(At, 0, 1); PG8_STAGE(PG8_SB(0, 0), b2, voffB); PG8_STAGE(PG8_SB(0, 1), b2 + hstep, voffB); PG8_STAGE(PG8_SA(0, 0), a2, voffA);
            PG8_WAIT_V(8); PG8_WAIT_L(0); PG8_BAR; PG8_MMA(1, 0, At, B0); PG8_MMA(1, 1, At, B1); PG8_BAR; PG8_SCHED;
            PG8_LDB(B0, 1, 0); PG8_LDB(B1, 1, 1); PG8_SCHED; PG8_LDA(At, 1, 0); PG8_STAGE(PG8_SA(0, 1), a2 + hstep, voffA);
            PG8_WAIT_V(8); PG8_WAIT_L(0); PG8_BAR; PG8_MMA(0, 0, At, B0); PG8_MMA(0, 1, At, B1); PG8_BAR; PG8_SCHED;
            bool did0 = false;
            if constexpr (Epi::SPLIT) { if (last) {
                PG8_STAGE(PG8_SB(1, 0), b3, voffB); PG8_STAGE(PG8_SB(1, 1), b3 + hstep, voffB); PG8_STAGE(PG8_SA(1, 0), a3, voffA); PG8_SCHED;
                E.half(acc, cur, 0, wr, wc, fr, fq); PG8_ZERO(0); PG8_SCHED;
                PG8_LDA(At, 1, 1); did0 = true; } }
            if (!did0) { PG8_LDA(At, 1, 1); PG8_STAGE(PG8_SB(1, 0), b3, voffB); PG8_STAGE(PG8_SB(1, 1), b3 + hstep, voffB); PG8_STAGE(PG8_SA(1, 0), a3, voffA); }
            PG8_WAIT_V(8); PG8_WAIT_L(0); PG8_BAR; PG8_MMA(1, 0, At, B0); PG8_MMA(1, 1, At, B1); PG8_BAR; PG8_SCHED;
            } else {
            PG8_LDB(B0, 0, 0); PG8_SCHED; PG8_LDA(At, 0, 0); PG8_STAGE(PG8_SA(1, 1), a1 + hstep, voffA);
            PG8_WAIT_L(8); PG8_BAR; PG8_WAIT_L(0); PG8_MMA(0, 0, At, B0); PG8_BAR; PG8_SCHED;
            PG8_LDB(B1, 0, 1); PG8_STAGE(PG8_SB(0, 0), b2, voffB);
            PG8_BAR; PG8_WAIT_L(0); PG8_MMA(0, 1, At, B1); PG8_BAR;
            PG8_LDA(At, 0, 1); PG8_STAGE(PG8_SA(0, 0), a2, voffA);
            PG8_BAR; PG8_WAIT_L(0); PG8_MMA(1, 0, At, B0); PG8_BAR; PG8_SCHED;
            PG8_STAGE(PG8_SB(0, 1), b2 + hstep, voffB);
            PG8_WAIT_V(6); PG8_BAR; PG8_MMA(1, 1, At, B1); PG8_BAR;
            PG8_LDB(B0, 1, 0); PG8_SCHED; PG8_LDA(At, 1, 0); PG8_STAGE(PG8_SA(0, 1), a2 + hstep, voffA);
            PG8_WAIT_L(8); PG8_BAR; PG8_WAIT_L(0); PG8_MMA(0, 0, At, B0); PG8_BAR; PG8_SCHED;
            PG8_LDB(B1, 1, 1); PG8_STAGE(PG8_SB(1, 0), b3, voffB);
            PG8_BAR; PG8_WAIT_L(0); PG8_MMA(0, 1, At, B1); PG8_BAR;
            PG8_LDA(At, 1, 1); PG8_STAGE(PG8_SA(1, 0), a3, voffA);
            PG8_BAR; PG8_WAIT_L(0); PG8_MMA(1, 0, At, B0); PG8_BAR; PG8_SCHED;
            PG8_STAGE(PG8_SB(1, 1), b3 + hstep, voffB);
            PG8_WAIT_V(6); PG8_BAR; PG8_MMA(1, 1, At, B1); PG8_BAR;
            }
        }
        if constexpr (Epi::SPLIT) { static_assert(!Epi::SPLIT || (SP2 && !ALIGN_EPI), "split epilogue: SP2 loop, no alignment barriers"); pending = true; prev = cur; if (!has_next) break; cur = nxt; cA = nA; cB = nB; ++ui; continue; }
        else {
        if constexpr (ALIGN_EPI) { if (wr == 0) PG8_BAR; }
        bool keep = false;
        if constexpr (Epi::DUAL) { if (cur.sel == 0) { E.mid(acc, cur, wr, wc, fr, fq); keep = true; } else E(acc, cur, wr, wc, fr, fq); }
        else E(acc, cur, wr, wc, fr, fq);
        if (!has_next) break;
        if (!keep) {
#pragma unroll
        for (int a = 0; a < 2; ++a)
#pragma unroll
            for (int b = 0; b < 2; ++b)
#pragma unroll
                for (int m = 0; m < 4; ++m)
#pragma unroll
                    for (int n = 0; n < 2; ++n) acc[a][b][m][n] = acc_t{};
        }
        cur = nxt; cA = nA; cB = nB; ++ui;
        if constexpr (ALIGN_EPI) { if (wr == 1) PG8_BAR; }
        }
    }
    if constexpr (Epi::SPLIT) { if (pending) E.half(acc, prev, 1, wr, wc, fr, fq); }
    PG8_WAIT_V(0);
    if constexpr (!ALIGN_EPI) { if (wr == 0) PG8_BAR; }
    PG8_BAR;
#undef PG8_SA
#undef PG8_SB
#undef PG8_STAGE
#undef PG8_LDA
#undef PG8_LDB
#undef PG8_MMA
#undef PG8_MMA_I8
#undef PG8_ADDR
#undef PG8_ITER
#undef PG8_ITERR
#undef PG8_ITERP
#undef PG8_ITERPF
#undef PG8_RAF
#undef PG8_RDP
#undef PG8_ADDP
#undef PG8_WAIT_V
#undef PG8_WAIT_L
#undef PG8_BAR
#undef PG8_SCHED
#undef PG8_ZERO
#undef PG8_ABASE
#undef PG8_BBASE
}
}

#ifndef PG8_SP2
#define PG8_SP2 true
#endif
#ifndef PG8_ALIGN
#define PG8_ALIGN true
#endif

constexpr int NWAVES = 8;
constexpr int BATCH = 8, SEQ = 4096, D = 1024, FF = 2816, DIN = 7168, CA = 31, CB = 3;
constexpr int M = BATCH * SEQ;
constexpr float EPS = 1e-6f;
constexpr int N_PHASES = 9;

constexpr size_t MiB = 1u << 20;
constexpr size_t WS_CTL = 0, CTL_ZERO_BYTES = 192 * 1024;
constexpr size_t CTL_COLMAX1 = 65536, CTL_COLMAX2 = 65536 + 24576;
constexpr int CW_PANEL2 = 32768;
constexpr size_t WS_SSP1 = 1 * MiB, WS_SSP2 = 3 * MiB, WS_SSP3 = 5 * MiB;
constexpr size_t WS_W1 = 8 * MiB, WS_WD1 = 19 * MiB, WS_WIN = 25 * MiB, WS_WA = 39 * MiB, WS_WB = 41 * MiB, WS_WO = 43 * MiB, WS_W2 = 45 * MiB, WS_WD2 = 56 * MiB;
constexpr size_t WS_RA = 64 * MiB;
constexpr size_t WS_Z = 128 * MiB;
constexpr size_t WS_HID = 128 * MiB;
constexpr size_t WS_QA = 448 * MiB;
constexpr size_t WS_XBUF2 = 480 * MiB;
constexpr size_t WS_XBUF3 = 481 * MiB;
constexpr size_t WS_WINQ = 484 * MiB;
constexpr size_t WS_END = 491 * MiB;
constexpr int CW_PANEL3 = 40960;
constexpr size_t WS_SBA = 7 * MiB + 512 * 1024 + 96 * 1024;
constexpr size_t WS_RSA = 2 * MiB;
constexpr size_t WS_SBIN = 7 * MiB + 512 * 1024 + 64 * 1024;
constexpr size_t WS_SB1 = 7 * MiB + 512 * 1024, WS_SB2 = WS_SB1 + 32 * 1024;
constexpr size_t ZS = (size_t)M * D;
constexpr size_t ZK = (size_t)4096 * D, ZX = 2 * ZK, HX = (3 * ZK * 2 - (size_t)4096 * FF * 2) / 2;
constexpr size_t HBX = ZK;
static_assert(WS_W1 + (size_t)2 * FF * D * 2 <= WS_WD1 && WS_WD1 + (size_t)D * FF * 2 <= WS_WIN && WS_WIN + (size_t)DIN * D * 2 <= WS_WA && WS_W2 + (size_t)2 * FF * D * 2 <= WS_WD2 && WS_WD2 + (size_t)D * FF * 2 <= WS_RA, "weights map");
static_assert((size_t)4096 * FF * 2 <= 3 * ZK * 2 && 8 * 3 * ZK == 3 * ZS && WS_Z + 5 * ZS * 2 <= WS_END && HBX * 2 * 2 == (size_t)4096 * D * 4, "activation map: eight 24-MiB sequence slabs (Z0|Z1|Z2, overlaid by that sequence's HID rows), Z3, Z4 behind them; h1 parked in half of the sequence's own output rows");
constexpr int CW_BAR = 1024;
constexpr int CW_LANEXCD = 7168;
constexpr int CW_ROWCTR = 6144;
constexpr int CW_PANEL = 8192;
constexpr size_t WS_XBUF = 7 * MiB;

constexpr int RING_BYTES = 131072;
constexpr int LDSCTL_OFF = RING_BYTES, MISC_OFF = LDSCTL_OFF + 320;
constexpr int LDS_BYTES = 147456;

#define GAS __attribute__((address_space(1)))
#define LAS __attribute__((address_space(3)))
typedef unsigned short bf16;
typedef unsigned v4u __attribute__((ext_vector_type(4)));
typedef unsigned v2u __attribute__((ext_vector_type(2)));
typedef float f32x4 __attribute__((ext_vector_type(4)));
typedef float f32x2 __attribute__((ext_vector_type(2)));
typedef GAS unsigned gu32;
#define RLX_AGENT __ATOMIC_RELAXED, __HIP_MEMORY_SCOPE_AGENT
#define LDS_WAIT() asm volatile("s_waitcnt lgkmcnt(0)" ::: "memory")
#define VM_WAIT() asm volatile("s_waitcnt vmcnt(0)" ::: "memory")
__device__ __forceinline__ unsigned f2bf(float f) { unsigned u = __builtin_bit_cast(unsigned, f); return (u + 0x7fffu + ((u >> 16) & 1u)) >> 16; }
__device__ __forceinline__ unsigned pk2(float lo, float hi) { return f2bf(lo) | (f2bf(hi) << 16); }
__device__ __forceinline__ float bflo(unsigned x) { return __builtin_bit_cast(float, x << 16); }
__device__ __forceinline__ float bfhi(unsigned x) { return __builtin_bit_cast(float, x & 0xffff0000u); }
__device__ __forceinline__ float fast_exp(float x) { return __builtin_amdgcn_exp2f(x * 1.44269504089f); }
__device__ __forceinline__ float fast_rcp(float x) { return __builtin_amdgcn_rcpf(x); }
__device__ __forceinline__ float sigmoidf_(float x) { return fast_rcp(1.0f + fast_exp(-x)); }

#define XB_TMO      128
#define XB_XCNT(j)  (256  + 64 * (j))
#define XB_XSUB(j)  (1280 + 64 * (j))
#define XB_XGEN(j)  (2304 + 64 * (j))
#define XB_TOP      3328
#define XB_TOPGEN   3392
#define XCD_BAR_WORDS 3456
#define XB_SPIN_CAP (1u << 18)
static_assert((CW_BAR + XCD_BAR_WORDS) * 4 <= (int)CTL_ZERO_BYTES, "barrier words inside the memset region");
__device__ __forceinline__ unsigned xb_ld(unsigned* p)              { return __hip_atomic_load(p, __ATOMIC_RELAXED, __HIP_MEMORY_SCOPE_AGENT); }
__device__ __forceinline__ unsigned xb_add(unsigned* p, unsigned v) { return __hip_atomic_fetch_add(p, v, __ATOMIC_RELAXED, __HIP_MEMORY_SCOPE_AGENT); }
__device__ __forceinline__ unsigned xb_xcc_id() { return (unsigned)__builtin_amdgcn_s_getreg((3 << 11) | 20) & 0xFu; }
#define XB_SPIN(cond, bar) do { unsigned _sp = 0; while (cond) { __builtin_amdgcn_s_sleep(1); \
    if ((++_sp & 255u) == 0u) { if (xb_ld(&(bar)[XB_TMO])) break; if (_sp > XB_SPIN_CAP) { atomicAdd(&(bar)[XB_TMO], 1u); break; } } } } while (0)
struct XcdBarrier { unsigned* bar; unsigned x; volatile LAS unsigned* st; };
__device__ __forceinline__ XcdBarrier xcd_barrier_post(unsigned* bar, volatile LAS unsigned* st) {
    XcdBarrier b; b.bar = bar; b.x = xb_xcc_id(); b.st = st;
    if (threadIdx.x == 0) (void)xb_add(&bar[XB_XCNT(b.x)], 1u);
    return b;
}
__device__ __forceinline__ void xcd_barrier_complete(unsigned* bar, unsigned x, unsigned& nloc, unsigned& nx) {
    const unsigned G = gridDim.x * gridDim.y * gridDim.z;
    unsigned sum, cnt, mine, sp = 0u;
    for (;;) {
        sum = 0u; cnt = 0u; mine = 0u;
#pragma unroll
        for (unsigned j = 0; j < 16; ++j) { const unsigned c = xb_ld(&bar[XB_XCNT(j)]); sum += c; cnt += (c > 0u) ? 1u : 0u; mine = (j == x) ? c : mine; }
        if (sum == G) break;
        __builtin_amdgcn_s_sleep(1);
        if ((++sp & 255u) == 0u) { if (xb_ld(&bar[XB_TMO])) break; if (sp > XB_SPIN_CAP) { atomicAdd(&bar[XB_TMO], 1u); break; } }
    }
    nloc = mine > 0u ? mine : 1u; nx = cnt > 0u ? cnt : 1u;
}
__device__ __forceinline__ void xcd_barrier(const XcdBarrier& b) {
    asm volatile("s_waitcnt vmcnt(0)" ::: "memory");
    __syncthreads();
    if (threadIdx.x == 0) {
        unsigned* bar = b.bar;
        __builtin_amdgcn_s_waitcnt(0);
        unsigned nloc = b.st[0], nx = b.st[1];
        if (nloc == 0u) { xcd_barrier_complete(bar, b.x, nloc, nx); b.st[0] = nloc; b.st[1] = nx; }
        const unsigned old = xb_add(&bar[XB_XSUB(b.x)], 1u);
        const unsigned gen = old / nloc;
        if (old + 1u == (gen + 1u) * nloc) {
            __builtin_amdgcn_fence(__ATOMIC_RELEASE, "agent");
            asm volatile("s_waitcnt vmcnt(0)" ::: "memory");
            const unsigned og = xb_add(&bar[XB_TOP], 1u);
            const unsigned tg = og / nx;
            if (og + 1u == (tg + 1u) * nx) xb_add(&bar[XB_TOPGEN], 1u);
            else XB_SPIN(xb_ld(&bar[XB_TOPGEN]) == tg, bar);
            __builtin_amdgcn_fence(__ATOMIC_ACQUIRE, "agent");
            xb_add(&bar[XB_XGEN(b.x)], 1u);
            asm volatile("s_waitcnt vmcnt(0)" ::: "memory");
        } else {
            XB_SPIN(xb_ld(&bar[XB_XGEN(b.x)]) == gen, bar);
            __builtin_amdgcn_fence(__ATOMIC_ACQUIRE, "agent");
            asm volatile("s_waitcnt vmcnt(0)" ::: "memory");
        }
    }
    __syncthreads();
}

__device__ __forceinline__ void xcd_barrier_local(const XcdBarrier& b) {
    asm volatile("s_waitcnt vmcnt(0)" ::: "memory");
    __syncthreads();
    if (threadIdx.x == 0) {
        unsigned* bar = b.bar;
        __builtin_amdgcn_s_waitcnt(0);
        const unsigned nloc = b.st[0];
        asm volatile("buffer_inv sc1" ::: "memory");
        const unsigned old = xb_add(&bar[XB_XSUB(b.x)], 1u);
        const unsigned gen = old / nloc;
        if (old + 1u == (gen + 1u) * nloc) (void)xb_add(&bar[XB_XGEN(b.x)], 1u);
        else XB_SPIN(xb_ld(&bar[XB_XGEN(b.x)]) == gen, bar);
        asm volatile("s_waitcnt vmcnt(0)" ::: "memory");
    }
    __syncthreads();
}

__device__ __forceinline__ float fq_sum(float s) {
    const unsigned u = __builtin_bit_cast(unsigned, s);
    auto r = __builtin_amdgcn_permlane16_swap(u, u, false, false);
    const float t = __builtin_bit_cast(float, (unsigned)r[0]) + __builtin_bit_cast(float, (unsigned)r[1]);
    const unsigned v = __builtin_bit_cast(unsigned, t);
    auto q = __builtin_amdgcn_permlane32_swap(v, v, false, false);
    return __builtin_bit_cast(float, (unsigned)q[0]) + __builtin_bit_cast(float, (unsigned)q[1]);
}
__device__ __forceinline__ float fq_max(float s) {
    const unsigned u = __builtin_bit_cast(unsigned, s);
    auto r = __builtin_amdgcn_permlane16_swap(u, u, false, false);
    const float t = fmaxf(__builtin_bit_cast(float, (unsigned)r[0]), __builtin_bit_cast(float, (unsigned)r[1]));
    const unsigned v = __builtin_bit_cast(unsigned, t);
    auto q = __builtin_amdgcn_permlane32_swap(v, v, false, false);
    return fmaxf(__builtin_bit_cast(float, (unsigned)q[0]), __builtin_bit_cast(float, (unsigned)q[1]));
}
__device__ __forceinline__ unsigned quant4(const f32x4& v, float inv) {
    unsigned u = 0u;
    u = __builtin_amdgcn_cvt_pk_u8_f32(__builtin_rintf(v[0] * inv) + 128.0f, 0, u);
    u = __builtin_amdgcn_cvt_pk_u8_f32(__builtin_rintf(v[1] * inv) + 128.0f, 1, u);
    u = __builtin_amdgcn_cvt_pk_u8_f32(__builtin_rintf(v[2] * inv) + 128.0f, 2, u);
    u = __builtin_amdgcn_cvt_pk_u8_f32(__builtin_rintf(v[3] * inv) + 128.0f, 3, u);
    return u ^ 0x80808080u;
}
__device__ __forceinline__ float row_rstd(const float* ssp, int row, int fq) {
    const f32x4 v = *(const f32x4*)(ssp + (size_t)row * 16 + 4 * fq);
    const float s = fq_sum((v.x + v.y) + (v.z + v.w));
    return rsqrtf(s * (1.0f / D) + EPS);
}
__device__ __forceinline__ v4u pack8(const f32x4& a, const f32x4& b) {
    v4u w; w.x = pg8::cvt_pk_bf16(a[0], a[1]); w.y = pg8::cvt_pk_bf16(a[2], a[3]); w.z = pg8::cvt_pk_bf16(b[0], b[1]); w.w = pg8::cvt_pk_bf16(b[2], b[3]); return w;
}
__device__ __forceinline__ void unpack8(const v4u& w, f32x4& a, f32x4& b) {
    a = (f32x4){bflo(w.x), bfhi(w.x), bflo(w.y), bfhi(w.y)}; b = (f32x4){bflo(w.z), bfhi(w.z), bflo(w.w), bfhi(w.w)};
}
__device__ __forceinline__ f32x2 lo2(const f32x4& v) { return (f32x2){v[0], v[1]}; }
__device__ __forceinline__ f32x2 hi2(const f32x4& v) { return (f32x2){v[2], v[3]}; }
__device__ __forceinline__ f32x4 cat2(const f32x2& a, const f32x2& b) { return (f32x4){a.x, a.y, b.x, b.y}; }
__device__ __forceinline__ f32x2 exp2_2(const f32x2& t) { return (f32x2){__builtin_amdgcn_exp2f(t.x), __builtin_amdgcn_exp2f(t.y)}; }
__device__ __forceinline__ f32x2 rcp_2(const f32x2& t) { return (f32x2){__builtin_amdgcn_rcpf(t.x), __builtin_amdgcn_rcpf(t.y)}; }
__device__ __forceinline__ f32x2 swiglu2(const f32x2& a, const f32x2& b, float c1, float c2i) {
    const f32x2 r = rcp_2(exp2_2(a * c1) * c2i + c2i); return (a * b) * r;
}
__device__ __forceinline__ f32x2 glu2(const f32x2& a, const f32x2& b, float c1, float rsi) {
    const f32x2 r = rcp_2(exp2_2(b * c1) * rsi + rsi); return a * r;
}
__device__ __forceinline__ f32x4 silu_mul4(const f32x4& g, const f32x4& u) {
    f32x4 o;
#pragma unroll
    for (int j = 0; j < 4; ++j) o[j] = g[j] * u[j] * sigmoidf_(g[j]);
    return o;
}
struct RstdStash {
    LAS float* T; const float* ssp; int p0, p1, p2, p3;
    template <class Sched> __device__ __forceinline__ void build(const Sched& S, int wr, int fr, int fq) {
        p0 = p1 = p2 = p3 = -1; int np = 0; pg8::Unit u;
        for (int i = 0; S.next(i, u); ++i) { if (u.pm != p0 && u.pm != p1 && u.pm != p2 && u.pm != p3 && np < 4) {
            if (np == 0) p0 = u.pm; else if (np == 1) p1 = u.pm; else if (np == 2) p2 = u.pm; else p3 = u.pm;
#pragma unroll
            for (int ai = 0; ai < 2; ++ai)
#pragma unroll
                for (int m = 0; m < 4; ++m) { const int rowl = ai * 128 + wr * 64 + m * 16 + fr; T[np * 256 + rowl] = row_rstd(ssp, u.pm * 256 + rowl, fq); }
            ++np; } }
        asm volatile("s_waitcnt vmcnt(0) lgkmcnt(0)" ::: "memory");
    }
    __device__ __forceinline__ int slot(int pm) const { return pm == p0 ? 0 : (pm == p1 ? 1 : (pm == p2 ? 2 : 3)); }
};
struct EpiSwiglu {
    static constexpr bool PERM = true, DUAL = false, SPLIT = false, STASH = true; typedef pg8::f32x4 acc_t;
    __device__ __forceinline__ void operator()(pg8::f32x4 (&acc)[2][2][4][2], const pg8::Unit& u, int wr, int wc, int fr, int fq) const { half(acc, u, 0, wr, wc, fr, fq); half(acc, u, 1, wr, wc, fr, fq); }
    bf16* H; mutable RstdStash st;
    template <class Sched> __device__ __forceinline__ void init(const Sched& S, int wr, int fr, int fq) const { st.build(S, wr, fr, fq); }
    __device__ __forceinline__ void half(pg8::f32x4 (&acc)[2][2][4][2], const pg8::Unit& u, int ai, int wr, int wc, int fr, int fq) const {
        asm volatile("" : "+v"(fr), "+v"(fq));
        const int row0 = u.pm * 256 + wr * 64 + fr, col0 = u.pn * 128 + wc * 32 + 8 * fq; const LAS float* Ts = st.T + st.slot(u.pm) * 256 + ai * 128 + wr * 64 + fr;
        float rsv[4];
#pragma unroll
        for (int m = 0; m < 4; ++m) rsv[m] = Ts[m * 16];
        asm volatile("s_waitcnt lgkmcnt(0)" : "+v"(rsv[0]), "+v"(rsv[1]), "+v"(rsv[2]), "+v"(rsv[3]));
#pragma unroll
        for (int m = 0; m < 4; ++m) {
            const int row = row0 + ai * 128 + m * 16; const float rs = rsv[m];
            const float c1 = rs * -1.44269504089f, c2 = __builtin_amdgcn_rcpf(rs * rs);
            const f32x4 g0 = acc[ai][0][m][0], g1 = acc[ai][0][m][1], u0 = acc[ai][1][m][0], u1 = acc[ai][1][m][1];
            const f32x4 h0 = cat2(swiglu2(lo2(g0), lo2(u0), c1, c2), swiglu2(hi2(g0), hi2(u0), c1, c2)), h1 = cat2(swiglu2(lo2(g1), lo2(u1), c1, c2), swiglu2(hi2(g1), hi2(u1), c1, c2));
            *(v4u*)(H + (size_t)row * FF + (size_t)(u.pm >> 4) * HX + col0) = pack8(h0, h1);
        }
    }
};
struct RowScaleStash {
    LAS float* T; const float* ri; int p0, p1, p2, p3; bool with_amax = true;
    template <class Sched> __device__ __forceinline__ void build(const Sched& S, int wr, int fr, int fq) {
        p0 = p1 = p2 = p3 = -1; int np = 0; pg8::Unit u;
        for (int i = 0; S.next(i, u); ++i) { if (u.pm != p0 && u.pm != p1 && u.pm != p2 && u.pm != p3 && np < 4) {
            if (np == 0) p0 = u.pm; else if (np == 1) p1 = u.pm; else if (np == 2) p2 = u.pm; else p3 = u.pm;
#pragma unroll
            for (int ai = 0; ai < 2; ++ai)
#pragma unroll
                for (int m = 0; m < 4; ++m) { const int rowl = ai * 128 + wr * 64 + m * 16 + fr; const f32x2 v = *(const f32x2*)(ri + 2 * (size_t)(u.pm * 256 + rowl));
                    T[np * 256 + rowl] = rsqrtf(v.x * (1.0f / D) + EPS) * (with_amax ? v.y * (1.0f / 127.0f) : 1.0f); }
            ++np; } }
        asm volatile("s_waitcnt vmcnt(0) lgkmcnt(0)" ::: "memory");
    }
    __device__ __forceinline__ int slot(int pm) const { return pm == p0 ? 0 : (pm == p1 ? 1 : (pm == p2 ? 2 : 3)); }
};
struct EpiSwigluQ {
    static constexpr bool PERM = true, DUAL = false, SPLIT = false, STASH = true; typedef pg8::i32x4 acc_t;
    bf16* H; const float* sB; mutable RowScaleStash st;
    template <class Sched> __device__ __forceinline__ void init(const Sched& S, int wr, int fr, int fq) const { st.build(S, wr, fr, fq); }
    __device__ __forceinline__ void operator()(pg8::i32x4 (&acc)[2][2][4][2], const pg8::Unit& u, int wr, int wc, int fr, int fq) const {
        const int row0 = u.pm * 256 + wr * 64 + fr, col0 = u.pn * 128 + wc * 32 + 8 * fq, gcol = u.pn * 256 + wc * 32 + 8 * fq;
        const f32x4 sg0 = *(const f32x4*)(sB + gcol), sg1 = *(const f32x4*)(sB + gcol + 4), su0 = *(const f32x4*)(sB + gcol + 128), su1 = *(const f32x4*)(sB + gcol + 132);
#pragma unroll
        for (int ai = 0; ai < 2; ++ai) {
            const LAS float* Ts = st.T + st.slot(u.pm) * 256 + ai * 128 + wr * 64 + fr;
            float rsv[4];
#pragma unroll
            for (int m = 0; m < 4; ++m) rsv[m] = Ts[m * 16];
            asm volatile("s_waitcnt lgkmcnt(0)" : "+v"(rsv[0]), "+v"(rsv[1]), "+v"(rsv[2]), "+v"(rsv[3]));
#pragma unroll
            for (int m = 0; m < 4; ++m) {
                const int row = row0 + ai * 128 + m * 16; const float rs = rsv[m];
                const float c1 = rs * -1.44269504089f, c2 = __builtin_amdgcn_rcpf(rs * rs);
                const f32x4 g0 = __builtin_convertvector(acc[ai][0][m][0], f32x4) * sg0, g1 = __builtin_convertvector(acc[ai][0][m][1], f32x4) * sg1;
                const f32x4 u0 = __builtin_convertvector(acc[ai][1][m][0], f32x4) * su0, u1 = __builtin_convertvector(acc[ai][1][m][1], f32x4) * su1;
                const f32x4 h0 = cat2(swiglu2(lo2(g0), lo2(u0), c1, c2), swiglu2(hi2(g0), hi2(u0), c1, c2)), h1 = cat2(swiglu2(lo2(g1), lo2(u1), c1, c2), swiglu2(hi2(g1), hi2(u1), c1, c2));
                *(v4u*)(H + (size_t)row * FF + (size_t)(u.pm >> 4) * HX + col0) = pack8(h0, h1);
            }
        }
    }
};
template <bool BASE_BF16> struct EpiResid {
    static constexpr bool PERM = true, DUAL = false, SPLIT = false, STASH = false; typedef pg8::f32x4 acc_t;
    const float* base; const bf16* baseb; bf16* hb; float* ssp; float alpha;
    __device__ __forceinline__ void operator()(pg8::f32x4 (&acc)[2][2][4][2], const pg8::Unit& u, int wr, int wc, int fr, int fq) const {
        const int row0 = u.pm * 256 + wr * 64 + fr, col0 = u.pn * 256 + wc * 32 + 8 * fq;
        if constexpr (BASE_BF16) {
            v4u rb[2][4][2];
#pragma unroll
            for (int ai = 0; ai < 2; ++ai)
#pragma unroll
                for (int m = 0; m < 4; ++m)
#pragma unroll
                    for (int bj = 0; bj < 2; ++bj) rb[ai][m][bj] = *(const v4u*)(baseb + (size_t)(row0 + ai * 128 + m * 16) * D + col0 + bj * 128);
#pragma unroll
            for (int ai = 0; ai < 2; ++ai)
#pragma unroll
                for (int m = 0; m < 4; ++m) {
                    const int row = row0 + ai * 128 + m * 16; const size_t off = (size_t)row * D + col0; float ss = 0.f;
#pragma unroll
                    for (int bj = 0; bj < 2; ++bj) {
                        f32x4 r0, r1; unpack8(rb[ai][m][bj], r0, r1);
                        const f32x4 v0 = r0 + acc[ai][bj][m][0] * alpha, v1 = r1 + acc[ai][bj][m][1] * alpha;
                        *(v4u*)(hb + off + bj * 128) = pack8(v0, v1);
                        const f32x4 q = v0 * v0 + v1 * v1; ss += (q[0] + q[1]) + (q[2] + q[3]);
                    }
                    ss = fq_sum(ss); if (fq == 0) ssp[(size_t)row * 16 + u.pn * 4 + wc] = ss;
                }
        } else {
#pragma unroll
            for (int ai = 0; ai < 2; ++ai) {
                f32x4 rf[4][2][2];
#pragma unroll
                for (int m = 0; m < 4; ++m)
#pragma unroll
                    for (int bj = 0; bj < 2; ++bj) { const float* p = base + (size_t)(row0 + ai * 128 + m * 16) * D + col0 + bj * 128; rf[m][bj][0] = *(const f32x4*)p; rf[m][bj][1] = *(const f32x4*)(p + 4); }
#pragma unroll
                for (int m = 0; m < 4; ++m) {
                    const int row = row0 + ai * 128 + m * 16; const size_t off = (size_t)row * D + col0; float ss = 0.f;
#pragma unroll
                    for (int bj = 0; bj < 2; ++bj) {
                        const f32x4 v0 = rf[m][bj][0] + acc[ai][bj][m][0] * alpha, v1 = rf[m][bj][1] + acc[ai][bj][m][1] * alpha;
                        *(v4u*)(hb + off + bj * 128) = pack8(v0, v1);
                        const f32x4 q = v0 * v0 + v1 * v1; ss += (q[0] + q[1]) + (q[2] + q[3]);
                    }
                    ss = fq_sum(ss); if (fq == 0) ssp[(size_t)row * 16 + u.pn * 4 + wc] = ss;
                }
                asm volatile("" ::: "memory");
            }
        }
    }
};
template <size_t HBX_, size_t PREX_, bool F32_ = false> struct EpiResidQT {
    static constexpr bool PERM = true, DUAL = false, SPLIT = false, STASH = false, PRE = true, PRE_F32 = F32_; static constexpr int PRE_LD = D; typedef pg8::f32x4 acc_t;
    __device__ __forceinline__ const bf16* pre_ptr() const { return baseb; }
    __device__ __forceinline__ float pre_scale() const { return 1.0f / alpha; }
    __device__ __forceinline__ size_t pre_lane() const { return PREX_; }
    const bf16* baseb; bf16* hb; unsigned char* qa; float* rowinfo; unsigned long long* xbuf; unsigned* cnt; LAS unsigned char* lds; float alpha;
    __device__ __forceinline__ void operator()(pg8::f32x4 (&acc)[2][2][4][2], const pg8::Unit& u, int wr, int wc, int fr, int fq) const {
        int tid = threadIdx.x; asm volatile("" : "+v"(tid), "+v"(fr), "+v"(fq));
        const int lane = tid & 63;
        LAS f32x2* P = (LAS f32x2*)(lds + RING_BYTES + 4096);
        LAS float* S = (LAS float*)(lds + RING_BYTES + 12288);
        const int col0 = u.pn * 256 + wc * 32 + 8 * fq;
#pragma unroll
        for (int ai = 0; ai < 2; ++ai)
#pragma unroll
            for (int m = 0; m < 4; ++m) {
                const int rowl = ai * 128 + wr * 64 + m * 16 + fr; float ss = 0.f, mx = 0.f;
#pragma unroll
                for (int bj = 0; bj < 2; ++bj) {
                    const f32x4 v0 = acc[ai][bj][m][0] * alpha, v1 = acc[ai][bj][m][1] * alpha;
                    acc[ai][bj][m][0] = v0; acc[ai][bj][m][1] = v1;
                    const f32x4 q = v0 * v0 + v1 * v1; ss += (q[0] + q[1]) + (q[2] + q[3]);
                    const f32x4 a0 = __builtin_elementwise_abs(v0), a1 = __builtin_elementwise_abs(v1);
                    mx = fmaxf(mx, fmaxf(fmaxf(fmaxf(a0[0], a0[1]), fmaxf(a0[2], a0[3])), fmaxf(fmaxf(a1[0], a1[1]), fmaxf(a1[2], a1[3]))));
                }
                ss = fq_sum(ss); mx = fq_max(mx); if (fq == 0) P[rowl * 4 + wc] = (f32x2){ss, mx};
            }
        asm volatile("s_waitcnt lgkmcnt(0)" ::: "memory"); __builtin_amdgcn_s_barrier(); asm volatile("" ::: "memory");
        if (tid < 256) { const f32x2 a = P[tid * 4 + 0], b = P[tid * 4 + 1], c = P[tid * 4 + 2], d = P[tid * 4 + 3];
            const float sst = (a.x + b.x) + (c.x + d.x), mxt = fmaxf(fmaxf(a.y, b.y), fmaxf(c.y, d.y));
            __hip_atomic_store(xbuf + ((size_t)(u.pm * 4 + u.pn) * 256 + tid), ((unsigned long long)__builtin_bit_cast(unsigned, mxt) << 32) | __builtin_bit_cast(unsigned, sst), RLX_AGENT); }
        asm volatile("s_waitcnt vmcnt(0)" ::: "memory");
        if (tid < 256 && lane == 0) __hip_atomic_fetch_add(cnt + 64 * u.pm, 1u, RLX_AGENT);
#pragma unroll
        for (int ai = 0; ai < 2; ++ai)
#pragma unroll
            for (int m = 0; m < 4; ++m) {
                const size_t off = (size_t)(u.pm * 256 + ai * 128 + wr * 64 + m * 16 + fr) * D + col0;
#pragma unroll
                for (int bj = 0; bj < 2; ++bj) *(v4u*)(hb + (size_t)(u.pm >> 4) * HBX_ + off + bj * 128) = pack8(acc[ai][bj][m][0], acc[ai][bj][m][1]);
            }
        if (tid < 64) {
            unsigned sp = 0;
            while ((unsigned)__builtin_amdgcn_readfirstlane(__hip_atomic_load(cnt + 64 * u.pm, RLX_AGENT)) < 16u) { __builtin_amdgcn_s_sleep(2); if (++sp > (1u << 22)) break; }
        }
        asm volatile("s_waitcnt lgkmcnt(0)" ::: "memory"); __builtin_amdgcn_s_barrier(); asm volatile("" ::: "memory");
        if (tid < 256) { float sst = 0.f, mxt = 0.f;
#pragma unroll
            for (int q = 0; q < 4; ++q) { const unsigned long long w = __hip_atomic_load(xbuf + ((size_t)(u.pm * 4 + q) * 256 + tid), RLX_AGENT);
                sst += __builtin_bit_cast(float, (unsigned)w); mxt = fmaxf(mxt, __builtin_bit_cast(float, (unsigned)(w >> 32))); }
            mxt = fmaxf(mxt, 1e-20f);
            S[tid] = 127.0f / mxt;
            if (u.pn == 0) *(f32x2*)(rowinfo + 2 * (size_t)(u.pm * 256 + tid)) = (f32x2){sst, mxt}; }
        asm volatile("s_waitcnt lgkmcnt(0)" ::: "memory"); __builtin_amdgcn_s_barrier(); asm volatile("" ::: "memory");
#pragma unroll
        for (int ai = 0; ai < 2; ++ai)
#pragma unroll
            for (int m = 0; m < 4; m += 2) {
                const int rowl = ai * 128 + wr * 64 + m * 16 + fr; const float inv0 = S[rowl], inv1 = S[rowl + 16];
                const size_t off = (size_t)(u.pm * 256 + rowl + (fq & 1) * 16) * D + col0 - 8 * (fq & 1);
#pragma unroll
                for (int bj = 0; bj < 2; ++bj) {
                    const unsigned a0 = quant4(acc[ai][bj][m][0], inv0), a1 = quant4(acc[ai][bj][m][1], inv0), b0 = quant4(acc[ai][bj][m + 1][0], inv1), b1 = quant4(acc[ai][bj][m + 1][1], inv1);
                    auto rx = __builtin_amdgcn_permlane16_swap(a0, b0, false, false); auto ry = __builtin_amdgcn_permlane16_swap(a1, b1, false, false);
                    v4u w; w.x = rx[0]; w.y = ry[0]; w.z = rx[1]; w.w = ry[1];
                    *(v4u*)(qa + off + bj * 128) = w;
                }
            }
    }
};
struct EpiFinal {
    static constexpr bool PERM = true, DUAL = false, SPLIT = false, STASH = false, PRE = true, PRE_F32 = false; static constexpr int PRE_LD = D; typedef pg8::f32x4 acc_t;
    __device__ __forceinline__ const bf16* pre_ptr() const { return hb; }
    __device__ __forceinline__ float pre_scale() const { return 1.0f / alpha; }
    __device__ __forceinline__ size_t pre_lane() const { return 0; }
    const bf16* hb; float* out; const float* gf; float* xbuf; unsigned* cnt; LAS unsigned char* lds; float alpha; float probe_add;
    __device__ __forceinline__ void operator()(pg8::f32x4 (&acc)[2][2][4][2], const pg8::Unit& u, int wr, int wc, int fr, int fq) const {
        int tid = threadIdx.x; asm volatile("" : "+v"(tid), "+v"(fr), "+v"(fq));
        const int lane = tid & 63;
        LAS float* P = (LAS float*)(lds + RING_BYTES + 4096);
        LAS float* S = (LAS float*)(lds + RING_BYTES + 8192);
        const int col0 = u.pn * 256 + wc * 32 + 8 * fq;
        f32x4 gv[2][2];
#pragma unroll
        for (int bj = 0; bj < 2; ++bj) { gv[bj][0] = *(const f32x4*)(gf + col0 + bj * 128); gv[bj][1] = *(const f32x4*)(gf + col0 + bj * 128 + 4); }
#pragma unroll
        for (int ai = 0; ai < 2; ++ai)
#pragma unroll
            for (int m = 0; m < 4; ++m) {
                const int rowl = ai * 128 + wr * 64 + m * 16 + fr; float ss = 0.f;
#pragma unroll
                for (int bj = 0; bj < 2; ++bj) {
                    const f32x4 v0 = acc[ai][bj][m][0] * alpha, v1 = acc[ai][bj][m][1] * alpha;
                    acc[ai][bj][m][0] = v0 * gv[bj][0]; acc[ai][bj][m][1] = v1 * gv[bj][1];
                    ss += ((v0[0] * v0[0] + v0[1] * v0[1]) + (v0[2] * v0[2] + v0[3] * v0[3])) + ((v1[0] * v1[0] + v1[1] * v1[1]) + (v1[2] * v1[2] + v1[3] * v1[3]));
                }
                ss = fq_sum(ss); if (fq == 0) P[rowl * 4 + wc] = ss;
            }
        asm volatile("s_waitcnt lgkmcnt(0)" ::: "memory"); __builtin_amdgcn_s_barrier(); asm volatile("" ::: "memory");
        if (tid < 256) { const f32x4 p = *(const LAS f32x4*)(P + tid * 4);
            __hip_atomic_store(xbuf + ((size_t)(u.pm * 4 + u.pn) * 256 + tid), (p.x + p.y) + (p.z + p.w), RLX_AGENT); }
        asm volatile("s_waitcnt vmcnt(0)" ::: "memory");
        if (tid < 256 && lane == 0) __hip_atomic_fetch_add(cnt + 64 * u.pm, 1u, RLX_AGENT);
        if (tid < 64) {
            unsigned sp = 0;
            while ((unsigned)__builtin_amdgcn_readfirstlane(__hip_atomic_load(cnt + 64 * u.pm, RLX_AGENT)) < 16u) { __builtin_amdgcn_s_sleep(2); if (++sp > (1u << 22)) break; }
        }
        asm volatile("s_waitcnt lgkmcnt(0)" ::: "memory"); __builtin_amdgcn_s_barrier(); asm volatile("" ::: "memory");
        if (tid < 256) { float t = 0.f;
#pragma unroll
            for (int q = 0; q < 4; ++q) t += __hip_atomic_load(xbuf + ((size_t)(u.pm * 4 + q) * 256 + tid), RLX_AGENT);
            S[tid] = rsqrtf(t * (1.0f / D) + EPS); }
        asm volatile("s_waitcnt lgkmcnt(0)" ::: "memory"); __builtin_amdgcn_s_barrier(); asm volatile("" ::: "memory");
#pragma unroll
        for (int ai = 0; ai < 2; ++ai)
#pragma unroll
            for (int m = 0; m < 4; ++m) {
                const int rowl = ai * 128 + wr * 64 + m * 16 + fr; const size_t off = (size_t)(u.pm * 256 + rowl) * D + col0; const float rs = S[rowl];
#pragma unroll
                for (int bj = 0; bj < 2; ++bj) {
                    f32x4 o0 = acc[ai][bj][m][0] * rs, o1 = acc[ai][bj][m][1] * rs;
#ifdef MK_PROBE
                    if (off + bj * 128 == 0) o0[0] += probe_add;
#endif
                    *(f32x4*)(out + off + bj * 128) = o0; *(f32x4*)(out + off + bj * 128 + 4) = o1;
                }
            }
    }
};
struct EpiZin {
    static constexpr bool PERM = true, DUAL = false, SPLIT = false, STASH = true; typedef pg8::f32x4 acc_t;
    typedef RowScaleStash stash_t;
    __device__ __forceinline__ void operator()(pg8::f32x4 (&acc)[2][2][4][2], const pg8::Unit& u, int wr, int wc, int fr, int fq) const { half(acc, u, 0, wr, wc, fr, fq); half(acc, u, 1, wr, wc, fr, fq); }
    bf16* Z; mutable RowScaleStash st;
    template <class Sched> __device__ __forceinline__ void init(const Sched& S, int wr, int fr, int fq) const { st.build(S, wr, fr, fq); }
    __device__ __forceinline__ void half(pg8::f32x4 (&acc)[2][2][4][2], const pg8::Unit& u, int ai, int wr, int wc, int fr, int fq) const {
        asm volatile("" : "+v"(fr), "+v"(fq));
        const int row0 = u.pm * 256 + wr * 64 + fr; const int type = u.pn >> 3;
        const int cpair = (u.pn & 7) * 128 + wc * 32 + 8 * fq, cb = (u.pn - 24) * 256 + wc * 32 + 8 * fq;
        const LAS float* Ts = st.T + st.slot(u.pm) * 256 + ai * 128 + wr * 64 + fr;
        float rsv[4];
#pragma unroll
        for (int m = 0; m < 4; ++m) rsv[m] = Ts[m * 16];
        asm volatile("s_waitcnt lgkmcnt(0)" : "+v"(rsv[0]), "+v"(rsv[1]), "+v"(rsv[2]), "+v"(rsv[3]));
#pragma unroll
        for (int m = 0; m < 4; ++m) {
            const int row = row0 + ai * 128 + m * 16; const float rs = rsv[m];
            const float c1 = rs * -1.44269504089f, c2 = rs * rs;
            const f32x4 p0 = acc[ai][0][m][0], p1 = acc[ai][0][m][1], q0 = acc[ai][1][m][0], q1 = acc[ai][1][m][1];
            if (type == 0) {
                const float rsi = __builtin_amdgcn_rcpf(rs); const f32x4 o0 = cat2(glu2(lo2(p0), lo2(q0), c1, rsi), glu2(hi2(p0), hi2(q0), c1, rsi)), o1 = cat2(glu2(lo2(p1), lo2(q1), c1, rsi), glu2(hi2(p1), hi2(q1), c1, rsi));
                *(v4u*)(Z + (size_t)(u.pm >> 4) * ZX + (size_t)row * D + cpair) = pack8(o0, o1);
            } else if (type == 1) {
                *(v4u*)(Z + ZK + (size_t)(u.pm >> 4) * ZX + (size_t)row * D + cpair) = pack8((p0 * q0) * c2, (p1 * q1) * c2);
            } else if (type == 2) {
                f32x4 r[2], sg[2];
#pragma unroll
                for (int h = 0; h < 2; ++h) {
                    const f32x4 pa = h ? p1 : p0, qa = h ? q1 : q0;
                    f32x4 ta = pa * c1, tb = qa * c1;
#pragma unroll
                    for (int j = 0; j < 4; ++j) { ta[j] = __builtin_amdgcn_fmed3f(ta[j], -86.56f, 86.56f); tb[j] = __builtin_amdgcn_fmed3f(tb[j], -86.56f, 86.56f); }
                    const f32x2 dal = exp2_2(lo2(ta)) + 1.0f, dah = exp2_2(hi2(ta)) + 1.0f, dbl = exp2_2(lo2(tb)) + 1.0f, dbh = exp2_2(hi2(tb)) + 1.0f;
                    r[h] = cat2(dbl * rcp_2(dal), dbh * rcp_2(dah)); sg[h] = cat2(rcp_2(dbl), rcp_2(dbh));
                }
                *(v4u*)(Z + 3 * ZS + (size_t)row * D + cpair) = pack8(r[0], r[1]);
                *(v4u*)(Z + 4 * ZS + (size_t)row * D + cpair) = pack8(sg[0], sg[1]);
            } else {
                *(v4u*)(Z + 2 * ZK + (size_t)(u.pm >> 4) * ZX + (size_t)row * D + cb) = pack8(p0 * rs, p1 * rs);
                *(v4u*)(Z + 2 * ZK + (size_t)(u.pm >> 4) * ZX + (size_t)row * D + cb + 128) = pack8(q0 * rs, q1 * rs);
            }
        }
    }
};
struct EpiZinQ {
    static constexpr bool PERM = true, DUAL = false, SPLIT = false, STASH = true; typedef pg8::i32x4 acc_t;
    typedef RowScaleStash stash_t;
    __device__ __forceinline__ void operator()(pg8::i32x4 (&acc)[2][2][4][2], const pg8::Unit& u, int wr, int wc, int fr, int fq) const { half(acc, u, 0, wr, wc, fr, fq); half(acc, u, 1, wr, wc, fr, fq); }
    bf16* Z; const float* sB; mutable RowScaleStash st;
    template <class Sched> __device__ __forceinline__ void init(const Sched& S, int wr, int fr, int fq) const { st.build(S, wr, fr, fq); }
    __device__ __forceinline__ void half(pg8::i32x4 (&acc)[2][2][4][2], const pg8::Unit& u, int ai, int wr, int wc, int fr, int fq) const {
        asm volatile("" : "+v"(fr), "+v"(fq));
        const int row0 = u.pm * 256 + wr * 64 + fr; const int type = u.pn >> 3;
        const int cpair = (u.pn & 7) * 128 + wc * 32 + 8 * fq, cb = (u.pn - 24) * 256 + wc * 32 + 8 * fq;
        const LAS float* Ts = st.T + st.slot(u.pm) * 256 + ai * 128 + wr * 64 + fr;
        const int gcol = u.pn * 256 + wc * 32 + 8 * fq;
        const f32x4 sp0 = *(const f32x4*)(sB + gcol), sp1 = *(const f32x4*)(sB + gcol + 4), sq0 = *(const f32x4*)(sB + gcol + 128), sq1 = *(const f32x4*)(sB + gcol + 132);
        float rsv[4];
#pragma unroll
        for (int m = 0; m < 4; ++m) rsv[m] = Ts[m * 16];
        asm volatile("s_waitcnt lgkmcnt(0)" : "+v"(rsv[0]), "+v"(rsv[1]), "+v"(rsv[2]), "+v"(rsv[3]));
#pragma unroll
        for (int m = 0; m < 4; ++m) {
            const int row = row0 + ai * 128 + m * 16; const float rs = rsv[m];
            const float c1 = rs * -1.44269504089f, c2 = rs * rs;
            const f32x4 p0 = __builtin_convertvector(acc[ai][0][m][0], f32x4) * sp0, p1 = __builtin_convertvector(acc[ai][0][m][1], f32x4) * sp1;
            const f32x4 q0 = __builtin_convertvector(acc[ai][1][m][0], f32x4) * sq0, q1 = __builtin_convertvector(acc[ai][1][m][1], f32x4) * sq1;
            if (type == 0) {
                const float rsi = __builtin_amdgcn_rcpf(rs); const f32x4 o0 = cat2(glu2(lo2(p0), lo2(q0), c1, rsi), glu2(hi2(p0), hi2(q0), c1, rsi)), o1 = cat2(glu2(lo2(p1), lo2(q1), c1, rsi), glu2(hi2(p1), hi2(q1), c1, rsi));
                *(v4u*)(Z + (size_t)(u.pm >> 4) * ZX + (size_t)row * D + cpair) = pack8(o0, o1);
            } else if (type == 1) {
                *(v4u*)(Z + ZK + (size_t)(u.pm >> 4) * ZX + (size_t)row * D + cpair) = pack8((p0 * q0) * c2, (p1 * q1) * c2);
            } else if (type == 2) {
                f32x4 r[2], sg[2];
#pragma unroll
                for (int h = 0; h < 2; ++h) {
                    const f32x4 pa = h ? p1 : p0, qa = h ? q1 : q0;
                    f32x4 ta = pa * c1, tb = qa * c1;
#pragma unroll
                    for (int j = 0; j < 4; ++j) { ta[j] = __builtin_amdgcn_fmed3f(ta[j], -86.56f, 86.56f); tb[j] = __builtin_amdgcn_fmed3f(tb[j], -86.56f, 86.56f); }
                    const f32x2 dal = exp2_2(lo2(ta)) + 1.0f, dah = exp2_2(hi2(ta)) + 1.0f, dbl = exp2_2(lo2(tb)) + 1.0f, dbh = exp2_2(hi2(tb)) + 1.0f;
                    r[h] = cat2(dbl * rcp_2(dal), dbh * rcp_2(dah)); sg[h] = cat2(rcp_2(dbl), rcp_2(dbh));
                }
                *(v4u*)(Z + 3 * ZS + (size_t)row * D + cpair) = pack8(r[0], r[1]);
                *(v4u*)(Z + 4 * ZS + (size_t)row * D + cpair) = pack8(sg[0], sg[1]);
            } else {
                *(v4u*)(Z + 2 * ZK + (size_t)(u.pm >> 4) * ZX + (size_t)row * D + cb) = pack8(p0 * rs, p1 * rs);
                *(v4u*)(Z + 2 * ZK + (size_t)(u.pm >> 4) * ZX + (size_t)row * D + cb + 128) = pack8(q0 * rs, q1 * rs);
            }
        }
    }
};
struct EpiMix {
    static constexpr bool PERM = true, DUAL = true, SPLIT = false, STASH = false, MIXED = true; typedef pg8::f32x4 acc_t;
    const bf16* ratio; const bf16* sgb; bf16* O; const float* rsA; const float* sBa;
    __device__ __forceinline__ void mid(pg8::f32x4 (&acc)[2][2][4][2], const pg8::Unit& u, int wr, int wc, int fr, int fq) const {
        const int row0 = u.pm * 256 + wr * 64 + fr, col0 = u.pn * 256 + wc * 32 + 8 * fq;
        f32x4 sc[2][2]; float rsv[2][4];
#pragma unroll
        for (int bj = 0; bj < 2; ++bj) { sc[bj][0] = *(const f32x4*)(sBa + col0 + bj * 128); sc[bj][1] = *(const f32x4*)(sBa + col0 + bj * 128 + 4); }
#pragma unroll
        for (int ai = 0; ai < 2; ++ai)
#pragma unroll
            for (int m = 0; m < 4; ++m) rsv[ai][m] = rsA[row0 + ai * 128 + m * 16];
        v4u gb[2][4][2];
#pragma unroll
        for (int ai = 0; ai < 2; ++ai)
#pragma unroll
            for (int m = 0; m < 4; ++m)
#pragma unroll
                for (int bj = 0; bj < 2; ++bj) gb[ai][m][bj] = *(const v4u*)(ratio + (size_t)(row0 + ai * 128 + m * 16) * D + col0 + bj * 128);
#pragma unroll
        for (int ai = 0; ai < 2; ++ai)
#pragma unroll
            for (int m = 0; m < 4; ++m)
#pragma unroll
                for (int bj = 0; bj < 2; ++bj) { f32x4 a, b; unpack8(gb[ai][m][bj], a, b); const float rs = rsv[ai][m];
                    acc[ai][bj][m][0] = __builtin_convertvector(__builtin_bit_cast(pg8::i32x4, acc[ai][bj][m][0]), f32x4) * (a * (sc[bj][0] * rs));
                    acc[ai][bj][m][1] = __builtin_convertvector(__builtin_bit_cast(pg8::i32x4, acc[ai][bj][m][1]), f32x4) * (b * (sc[bj][1] * rs)); }
    }
    __device__ __forceinline__ void operator()(pg8::f32x4 (&acc)[2][2][4][2], const pg8::Unit& u, int wr, int wc, int fr, int fq) const {
        const int row0 = u.pm * 256 + wr * 64 + fr, col0 = u.pn * 256 + wc * 32 + 8 * fq;
        v4u gb[2][4][2];
#pragma unroll
        for (int ai = 0; ai < 2; ++ai)
#pragma unroll
            for (int m = 0; m < 4; ++m)
#pragma unroll
                for (int bj = 0; bj < 2; ++bj) gb[ai][m][bj] = *(const v4u*)(sgb + (size_t)(row0 + ai * 128 + m * 16) * D + col0 + bj * 128);
#pragma unroll
        for (int ai = 0; ai < 2; ++ai)
#pragma unroll
            for (int m = 0; m < 4; ++m) {
                const size_t off = (size_t)(row0 + ai * 128 + m * 16) * D + col0;
#pragma unroll
                for (int bj = 0; bj < 2; ++bj) { f32x4 a, b; unpack8(gb[ai][m][bj], a, b);
                    *(v4u*)(O + (size_t)(u.pm >> 4) * ZX + off + bj * 128) = pack8(acc[ai][bj][m][0] * a, acc[ai][bj][m][1] * b); }
            }
    }
};

__device__ __forceinline__ float wave_sum(float v) {
#pragma unroll
    for (int o = 1; o < 64; o <<= 1) v += __shfl_xor(v, o);
    return v;
}
__device__ __forceinline__ void p0_transpose_item(const float* W, const float* gain, int K, int N, bf16* WT, int k0, int n0, int drow, LAS unsigned short* scr, int lane) {
    const int kr = lane >> 4, nc = lane & 15;
    f32x4 v[16];
#pragma unroll
    for (int i = 0; i < 16; ++i) v[i] = *(const GAS f32x4*)(W + (size_t)(k0 + 4 * i + kr) * N + n0 + 4 * nc);
#pragma unroll
    for (int i = 0; i < 16; ++i) { const int k = 4 * i + kr; const float gk = gain ? gain[k0 + k] : 1.0f; const f32x4 w = v[i] * gk;
        LAS unsigned* d = (LAS unsigned*)(scr + k * 66 + 4 * nc); d[0] = pk2(w.x, w.y); d[1] = pk2(w.z, w.w); }
    LDS_WAIT(); asm volatile("" ::: "memory");
    const int c = lane & 7;
#pragma unroll
    for (int j = 0; j < 8; ++j) { const int n = (lane >> 3) + 8 * j; const LAS unsigned short* sp = scr + (8 * c) * 66 + n;
        v4u o; o.x = (unsigned)sp[0] | ((unsigned)sp[66] << 16); o.y = (unsigned)sp[2 * 66] | ((unsigned)sp[3 * 66] << 16);
        o.z = (unsigned)sp[4 * 66] | ((unsigned)sp[5 * 66] << 16); o.w = (unsigned)sp[6 * 66] | ((unsigned)sp[7 * 66] << 16);
        *(GAS v4u*)(WT + (size_t)(drow + n) * K + k0 + 8 * c) = o; }
    LDS_WAIT(); asm volatile("" ::: "memory");
}
__device__ __forceinline__ int dest_row(int mode, int n0) {
    if (mode == 0) return n0;
    if (mode == 1) return 256 * (n0 >> 7) + (n0 & 127);
    if (mode == 2) return 256 * (n0 >> 7) + 128 + (n0 & 127);
    const int s = n0 >> 10, j = n0 & 1023, pj = 256 * (j >> 7) + (j & 127);
    switch (s) {
        case 0: return pj;
        case 1: return pj + 128;
        case 2: return 6144 + j;
        case 3: return 2048 + pj;
        case 4: return 2048 + pj + 128;
        case 5: return 4096 + pj;
        default: return 4096 + pj + 128;
    }
}
__device__ __forceinline__ void p0_weight(const float* W, const float* gain, int K, int N, bf16* WT, int mode, int item, LAS unsigned short* scr, int lane) {
    const int nblk = N / 64, kb = item / nblk, nb = item % nblk;
    p0_transpose_item(W, gain, K, N, WT, 64 * kb, 64 * nb, dest_row(mode, 64 * nb), scr, lane);
}

__device__ __forceinline__ void p0_quant_unit(const float* W, const float* gain, int N, unsigned char* WTq, int ldq, int n0, int drow, float* sB, LAS unsigned char* lds, int wave, int lane) {
    constexpr int K = D;
    const int kr = lane >> 4, nc = lane & 15;
    LAS f32x4* tbl = (LAS f32x4*)(lds + RING_BYTES + 1024);
    LAS unsigned char* scr = lds + wave * 16384;
    f32x4 v[2][16]; f32x4 mx = (f32x4){0.f, 0.f, 0.f, 0.f};
#pragma unroll
    for (int t = 0; t < 2; ++t)
#pragma unroll
        for (int i = 0; i < 16; ++i) v[t][i] = *(const GAS f32x4*)(W + (size_t)((2 * wave + t) * 64 + 4 * i + kr) * N + n0 + 4 * nc);
#pragma unroll
    for (int t = 0; t < 2; ++t)
#pragma unroll
        for (int i = 0; i < 16; ++i) { if (gain) v[t][i] = v[t][i] * gain[(2 * wave + t) * 64 + 4 * i + kr]; const f32x4 a = __builtin_elementwise_abs(v[t][i]);
            mx = (f32x4){fmaxf(mx[0], a[0]), fmaxf(mx[1], a[1]), fmaxf(mx[2], a[2]), fmaxf(mx[3], a[3])}; }
#pragma unroll
    for (int e = 0; e < 4; ++e) mx[e] = fq_max(mx[e]);
    if (kr == 0) tbl[wave * 16 + nc] = mx;
    __syncthreads();
    f32x4 cm = tbl[nc];
#pragma unroll
    for (int w = 1; w < 8; ++w) { const f32x4 o = tbl[w * 16 + nc]; cm = (f32x4){fmaxf(cm[0], o[0]), fmaxf(cm[1], o[1]), fmaxf(cm[2], o[2]), fmaxf(cm[3], o[3])}; }
    cm = (f32x4){fmaxf(cm[0], 1e-30f), fmaxf(cm[1], 1e-30f), fmaxf(cm[2], 1e-30f), fmaxf(cm[3], 1e-30f)};
    const f32x4 inv = (f32x4){127.0f / cm[0], 127.0f / cm[1], 127.0f / cm[2], 127.0f / cm[3]};
    if (wave == 0 && kr == 0) *(GAS f32x4*)(sB + drow + 4 * nc) = cm * (1.0f / 127.0f);
    const int c = lane & 3;
#pragma unroll
    for (int t = 0; t < 2; ++t) {
        const int k0 = (2 * wave + t) * 64;
#pragma unroll
        for (int i = 0; i < 16; ++i) *(LAS unsigned*)(scr + (4 * i + kr) * 68 + 4 * nc) = quant4(v[t][i] * inv, 1.0f);
        LDS_WAIT(); asm volatile("" ::: "memory");
#pragma unroll
        for (int j = 0; j < 4; ++j) { const int n = (lane >> 2) + 16 * j; const LAS unsigned char* sp = scr + (16 * c) * 68 + n; unsigned w[4];
#pragma unroll
            for (int d = 0; d < 4; ++d) w[d] = (unsigned)sp[(4 * d) * 68] | ((unsigned)sp[(4 * d + 1) * 68] << 8) | ((unsigned)sp[(4 * d + 2) * 68] << 16) | ((unsigned)sp[(4 * d + 3) * 68] << 24);
            *(GAS v4u*)(WTq + (size_t)(drow + n) * ldq + k0 + 16 * c) = (v4u){w[0], w[1], w[2], w[3]}; }
        LDS_WAIT(); asm volatile("" ::: "memory");
    }
    __syncthreads();
}
struct Args { const float* in[20]; float* out; unsigned char* ws; int ph_lo, ph_hi, use_bar, skip_b; };

__global__ void __launch_bounds__(NWAVES * 64, 2) mk_fwd(Args args) {
    extern __shared__ __attribute__((aligned(16))) unsigned char lds_raw[];
    LAS unsigned char* lds = (LAS unsigned char*)lds_raw;
    volatile LAS unsigned* MISC = (volatile LAS unsigned*)(lds + MISC_OFF);
    const int tid = threadIdx.x, lane = tid & 63, wave = __builtin_amdgcn_readfirstlane(tid >> 6);
    const int G = gridDim.x; const int bx = blockIdx.x; const int vcu = (G % 8 == 0) ? (bx % 8) * (G / 8) + bx / 8 : bx;
    unsigned char* ws = args.ws;
    gu32* ctl = (gu32*)(ws + WS_CTL);
    const float* x = args.in[0];
    float* out = args.out;
    float* ssp1 = (float*)(ws + WS_SSP1); float* ssp2 = (float*)(ws + WS_SSP2); float* ssp3 = (float*)(ws + WS_SSP3);
    bf16* W1 = (bf16*)(ws + WS_W1); bf16* WD1 = (bf16*)(ws + WS_WD1); bf16* WIN = (bf16*)(ws + WS_WIN); bf16* WA = (bf16*)(ws + WS_WA); bf16* WB = (bf16*)(ws + WS_WB);
    bf16* WO = (bf16*)(ws + WS_WO); bf16* W2 = (bf16*)(ws + WS_W2); bf16* WD2 = (bf16*)(ws + WS_WD2);
    bf16* RA = (bf16*)(ws + WS_RA); bf16* Z = (bf16*)(ws + WS_Z); bf16* HID = (bf16*)(ws + WS_HID);
    unsigned char* QA = ws + WS_QA; unsigned char* W1q = ws + WS_W1; unsigned char* W2q = ws + WS_W2;
    float* sB1 = (float*)(ws + WS_SB1); float* sB2 = (float*)(ws + WS_SB2);
    unsigned char* WINq = ws + WS_WINQ; float* sBin = (float*)(ws + WS_SBIN); float* rowinfo2 = ssp2;
    unsigned char* WAq = ws + WS_WA; float* sBa = (float*)(ws + WS_SBA); float* rsA = (float*)(ws + WS_RSA);
    float* rowinfo1 = ssp1; float* rowinfo3 = ssp3;
    bf16* HB1 = (bf16*)out;

    for (int u = tid; u < (LDS_BYTES - LDSCTL_OFF) / 4; u += NWAVES * 64) ((LAS unsigned*)(lds + LDSCTL_OFF))[u] = 0u;
    __syncthreads();
    XcdBarrier bar; bar.bar = (unsigned*)(ctl + CW_BAR); bar.x = 0; bar.st = nullptr;
    if (args.use_bar) { bar = xcd_barrier_post((unsigned*)(ctl + CW_BAR), MISC + 8);
        if (tid == 0) (void)__hip_atomic_fetch_or((unsigned*)(ctl + CW_LANEXCD) + 64 * (bx & 7), 1u << bar.x, __ATOMIC_RELAXED, __HIP_MEMORY_SCOPE_AGENT); }
    bool seam_local = false;
    const int lo = args.ph_lo, hi = args.ph_hi;
#define IN(k) (lo <= (k) && (k) < hi)
#ifdef MK_PROBE
    unsigned long long* const stamps = (unsigned long long*)(ws + 20480);
#define PSAVE(p) do { if (bx == 0 && tid == 0) { LAS unsigned long long* pk_ = (LAS unsigned long long*)(lds + 131072 + 64); stamps[16 + (p)] = pk_[1]; pk_[1] = 0ull; } } while (0)
#define SEAM(k) do { if (IN(k) && IN((k) + 1)) xcd_barrier(bar); if (bx == 0 && tid == 0) __hip_atomic_store(stamps + (k) + 1, __builtin_amdgcn_s_memrealtime(), RLX_AGENT); } while (0)
#define SEAM_L(k) do { if (IN(k) && IN((k) + 1)) { if (seam_local) xcd_barrier_local(bar); else xcd_barrier(bar); } if (bx == 0 && tid == 0) __hip_atomic_store(stamps + (k) + 1, __builtin_amdgcn_s_memrealtime(), RLX_AGENT); } while (0)
    if (bx == 0 && tid == 0) __hip_atomic_store(stamps, __builtin_amdgcn_s_memrealtime(), RLX_AGENT);
#else
#define PSAVE(p) do { } while (0)
#define SEAM(k) do { if (IN(k) && IN((k) + 1)) xcd_barrier(bar); } while (0)
#define SEAM_L(k) do { if (IN(k) && IN((k) + 1)) { if (seam_local) xcd_barrier_local(bar); else xcd_barrier(bar); } } while (0)
#endif

    if (IN(0)) {
        LAS unsigned short* scr = (LAS unsigned short*)(lds + wave * 16384);
        const int gw = vcu * NWAVES + wave, NGW = G * NWAVES;
        constexpr int I_GU = (D / 64) * (FF / 64), I_DN = (FF / 64) * (D / 64), I_IN = (D / 64) * (2 * D / 64)  , I_SQ = (D / 64) * (D / 64);
        constexpr int NITEMS = 4 * I_GU + 2 * I_DN + I_IN + 2 * I_SQ;
        constexpr int NQF = (MK_Q2 ? 4 : 2) * (FF / 64), NQW = NQF + 80, NQU = NQW + 16;
        for (int uq = vcu; uq < NQU; uq += G) {
            const float* Wp; const float* gp; unsigned char* Wq; float* sBp; int Nq, n0, mode, ldq = D;
            if (uq >= NQW) { n0 = 64 * (uq - NQW); Wp = args.in[11]; gp = nullptr; Wq = WAq; sBp = sBa; Nq = D; mode = 0; ldq = 2 * D; }
            else if (uq >= NQF) { const int q = uq - NQF, sg = q >> 4, seg = sg < 3 ? sg : sg + 2; n0 = seg * 1024 + 64 * (q & 15); Wp = args.in[6]; gp = args.in[5]; Wq = WINq; sBp = sBin; Nq = DIN; mode = 3; }
            else { const int w = uq / (FF / 64); n0 = 64 * (uq - w * (FF / 64)); Wp = w == 0 ? args.in[2] : (w == 1 ? args.in[3] : (w == 2 ? args.in[16] : args.in[17]));
                gp = w < 2 ? args.in[1] : args.in[15]; Wq = w < 2 ? W1q : W2q; sBp = w < 2 ? sB1 : sB2; Nq = FF; mode = 1 + (w & 1); }
            p0_quant_unit(Wp, gp, Nq, Wq, ldq, n0, dest_row(mode, n0), sBp, lds, wave, lane);
        }
        constexpr int NREST = NITEMS - 4 * I_GU + (MK_Q2 ? 0 : 2 * I_GU);
        const int nunit_wg = NQU < G ? NQU : G;
        const int nd = NQU > G ? NQU - G : 0;
        const int slots = (vcu < nd) ? 0 : ((vcu < nunit_wg) ? 1 : 2);
        const int vslot0 = (vcu < nunit_wg) ? (vcu - nd) * NWAVES + wave : (nunit_wg - nd) * NWAVES + ((vcu - nunit_wg) * NWAVES + wave) * 2;
        const int NVS = (nunit_wg - nd) * NWAVES + (G - nunit_wg) * NWAVES * 2;
        if (slots > 0)
        for (int it0 = vslot0; it0 < NREST; it0 += NVS)
        for (int sl = 0; sl < slots; ++sl) {
            int r = it0 + sl; if (r >= NREST) break;
            if (!MK_Q2) {
                if (r < I_GU) { p0_weight(args.in[16], args.in[15], D, FF, W2, 1, r, scr, lane); continue; } r -= I_GU;
                if (r < I_GU) { p0_weight(args.in[17], args.in[15], D, FF, W2, 2, r, scr, lane); continue; } r -= I_GU;
            }
            if (r < I_DN) { p0_weight(args.in[4], nullptr, FF, D, WD1, 0, r, scr, lane); continue; } r -= I_DN;
            if (r < I_IN) { const int kb = r / 32, n0 = 3072 + 64 * (r - kb * 32); p0_transpose_item(args.in[6], args.in[5], D, DIN, WIN, 64 * kb, n0, dest_row(3, n0), scr, lane); continue; } r -= I_IN;
            if (r < I_SQ) { p0_weight(args.in[13], nullptr, D, D, WB, 0, r, scr, lane); continue; } r -= I_SQ;
            if (r < I_SQ) { p0_weight(args.in[14], nullptr, D, D, WO, 0, r, scr, lane); continue; } r -= I_SQ;
            p0_weight(args.in[18], nullptr, FF, D, WD2, 0, r, scr, lane);
        }
        const bool dynrows = (G == 256);
        constexpr int TAIL0 = 3 * (M / 4), TGROUPS = (M / 4) / 4 / 8;
        unsigned* const rowctr = (unsigned*)(ctl + CW_ROWCTR) + 64 * (bx & 7);
        int nextg = 0;
        for (int it = 0;; ++it) {
            int m0, ms;
            if (!dynrows || it < 3) { m0 = gw + it * 4 * NGW; ms = NGW; if (m0 >= M) break;
                if (dynrows && it == 2) { int t_ = 0; if (lane == 0) t_ = (int)__hip_atomic_fetch_add(rowctr, 1u, RLX_AGENT); nextg = __builtin_amdgcn_readfirstlane(t_); } }
            else { const int gsel = nextg; if (gsel >= TGROUPS) break; m0 = TAIL0 + ((bx & 7) * TGROUPS + gsel) * 4; ms = 1;
                { int t_ = 0; if (lane == 0) t_ = (int)__hip_atomic_fetch_add(rowctr, 1u, RLX_AGENT); nextg = __builtin_amdgcn_readfirstlane(t_); } }
            f32x4 v[4][4];
#pragma unroll
            for (int r = 0; r < 4; ++r) { const int m = m0 + r * ms; if (m < M) { const GAS f32x4* xr = (const GAS f32x4*)(x + (size_t)m * D) + lane;
#pragma unroll
                for (int j = 0; j < 4; ++j) v[r][j] = xr[64 * j]; } }
#pragma unroll
            for (int r = 0; r < 4; ++r) { const int m = m0 + r * ms; if (m < M) { float sq = 0.f, mx = 0.f;
#pragma unroll
                for (int j = 0; j < 4; ++j) { sq += (v[r][j].x * v[r][j].x + v[r][j].y * v[r][j].y) + (v[r][j].z * v[r][j].z + v[r][j].w * v[r][j].w);
                    const f32x4 a = __builtin_elementwise_abs(v[r][j]); mx = fmaxf(mx, fmaxf(fmaxf(a.x, a.y), fmaxf(a.z, a.w))); }
                sq = wave_sum(sq);
#pragma unroll
                for (int o = 1; o < 64; o <<= 1) mx = fmaxf(mx, __shfl_xor(mx, o));
                mx = fmaxf(mx, 1e-20f); const float inv = 127.0f / mx;
                GAS unsigned* q4 = (GAS unsigned*)(QA + (size_t)m * D) + lane;
#pragma unroll
                for (int j = 0; j < 4; ++j) q4[64 * j] = quant4(v[r][j], inv);
                if (lane == 0) *(GAS f32x2*)(rowinfo1 + 2 * (size_t)m) = (f32x2){sq, mx}; } }
        }
    }
    SEAM(0);
    if (args.use_bar && IN(0) && IN(1)) {
        if (tid == 0) { unsigned ok = (G == 256) ? 1u : 0u;
#pragma unroll
            for (int j = 0; j < 8; ++j) { const unsigned m = xb_ld((unsigned*)(ctl + CW_LANEXCD) + 64 * j); ok &= (m != 0u && (m & (m - 1u)) == 0u) ? 1u : 0u; }
            MISC[10] = ok; }
        __syncthreads();
        seam_local = MISC[10] != 0u;
    }
    if (IN(1)) {
        pg8::Gemm g{(const bf16*)QA, (const bf16*)W1q, nullptr, nullptr, M, 2 * FF, D / 2}; pg8::StaticOrderT<M / 256, 2 * FF / 256> S; S.init(G, bx);
        EpiSwigluQ E{HID, sB1, RowScaleStash{(LAS float*)(lds + RING_BYTES + 1024), rowinfo1, -1, -1, -1, -1}};
        pg8::gemm_phase<EpiSwigluQ, pg8::StaticOrderT<M / 256, 2 * FF / 256>, true, true>(lds, g, S, E); PSAVE(1);
    }
    SEAM_L(1);
    if (IN(2)) {
        pg8::Gemm g{HID, WD1, nullptr, nullptr, M, D, FF, HX * 2, 0}; pg8::StaticOrderT<M / 256, D / 256> S; S.init(G, bx);
        typedef EpiResidQT<HBX, 0, true> EpiResidQ2;
        EpiResidQ2 E{(const bf16*)x, HB1, QA, rowinfo2, (unsigned long long*)(ws + WS_XBUF3), (unsigned*)(ctl + CW_PANEL3), lds, 0.5f};
        pg8::gemm_phase<EpiResidQ2, pg8::StaticOrderT<M / 256, D / 256>, PG8_ALIGN, PG8_SP2>(lds, g, S, E); PSAVE(2);
    }
    SEAM_L(2);
    if (IN(3)) {
        {   pg8::Gemm g{(const bf16*)QA, (const bf16*)WINq, nullptr, nullptr, M, DIN, D / 2}; pg8::MapOrderT<M / 256, 20, 0> S; S.init(G, bx);
            EpiZinQ E{Z, sBin, RowScaleStash{(LAS float*)(lds + RING_BYTES + 1024), rowinfo2, -1, -1, -1, -1, true}};
            pg8::gemm_phase<EpiZinQ, pg8::MapOrderT<M / 256, 20, 0>, true, true>(lds, g, S, E); }
        {   pg8::Gemm g{HB1, WIN, nullptr, nullptr, M, DIN, D, HBX * 2, 0}; pg8::MapOrderT<M / 256, 8, 1> S; S.init(G, bx);
            EpiZin E{Z, RowScaleStash{(LAS float*)(lds + RING_BYTES + 1024), rowinfo2, -1, -1, -1, -1, false}};
            pg8::gemm_phase<EpiZin, pg8::MapOrderT<M / 256, 8, 1>, true, true>(lds, g, S, E); PSAVE(3); }
    }
    SEAM_L(3);
    if (IN(4)) {
        const int c0 = 2 * tid;
        f32x2 wA[CA];
#pragma unroll
        for (int k = 0; k < CA; ++k) wA[k] = *(const f32x2*)(args.in[7] + (size_t)k * D + c0);
        const f32x2 cbias = *(const f32x2*)(args.in[8] + c0), lng = *(const f32x2*)(args.in[9] + c0), lnb = *(const f32x2*)(args.in[10] + c0);
        const int co = (tid & 127) * 8, tq = tid >> 7;
        f32x4 wB[3][2];
#pragma unroll
        for (int k = 0; k < 3; ++k) { wB[k][0] = *(const f32x4*)(args.in[12] + (size_t)k * D + co); wB[k][1] = *(const f32x4*)(args.in[12] + (size_t)k * D + co + 4); }

        LAS unsigned* tile32 = (LAS unsigned*)lds;
        LAS f32x2* P = (LAS f32x2*)(lds + RING_BYTES + 1024);
        LAS f32x2* Sx = (LAS f32x2*)(lds + RING_BYTES + 2048);
        LAS float* Pm = (LAS float*)(lds + RING_BYTES + 2304);
        LAS float* Sm = (LAS float*)(lds + RING_BYTES + 2816);
        constexpr int CHUNK = 128, NBLK = CHUNK / 16;
        const int pj = tid >> 7, pch = tid & 127;
        for (int chunk = vcu; chunk < M / CHUNK; chunk += G) {
            const int tg0 = chunk * CHUNK; const bool seq_start = (tg0 & (SEQ - 1)) == 0;
            const size_t zl = (size_t)(tg0 >> 12) * ZX;
            const bf16* Z0 = Z + zl; const bf16* Z1 = Z + ZK + zl; bf16* Z2 = Z + 2 * ZK + zl;
#pragma unroll
            for (int b = -2; b <= 0; ++b)
#pragma unroll
                for (int q = 0; q < 4; ++q) { const int j = pj + 4 * q;
                    v4u v = (v4u){0u, 0u, 0u, 0u}; if (!(b < 0 && seq_start)) v = *(const GAS v4u*)(Z0 + (size_t)(tg0 + 16 * b + j) * D + pch * 8);
                    *(LAS v4u*)(lds + (b + 2) * 32768 + j * 2048 + pch * 16) = v; }
            __syncthreads();
            for (int s = 0; s < NBLK; ++s) {
                const int t0 = tg0 + 16 * s;
                v4u pf[4];
                if (s + 1 < NBLK) {
#pragma unroll
                    for (int q = 0; q < 4; ++q) pf[q] = *(const GAS v4u*)(Z0 + (size_t)(t0 + 16 + pj + 4 * q) * D + pch * 8);
                }
                f32x2 a[16];
#pragma unroll
                for (int tt = 0; tt < 16; ++tt) a[tt] = cbias;
                const int rbase = 16 * s + 2;
#pragma unroll
                for (int r = 0; r < 46; ++r) {
                    const unsigned xv = tile32[((rbase + r) & 63) * 512 + tid]; const f32x2 xf = (f32x2){bflo(xv), bfhi(xv)};
#pragma unroll
                    for (int tt = 0; tt < 16; ++tt) { const int k = r - tt; if (k >= 0 && k < CA) a[tt] = xf * wA[k] + a[tt]; }
                }
                float v[32];
#pragma unroll
                for (int tt = 0; tt < 16; ++tt) { v[2 * tt] = a[tt].x + a[tt].y; v[2 * tt + 1] = a[tt].x * a[tt].x + a[tt].y * a[tt].y; }
#pragma unroll
                for (int i = 0; i < 16; ++i) { auto r = __builtin_amdgcn_permlane16_swap(__builtin_bit_cast(unsigned, v[i]), __builtin_bit_cast(unsigned, v[i + 16]), false, false);
                    v[i] = __builtin_bit_cast(float, (unsigned)r[0]) + __builtin_bit_cast(float, (unsigned)r[1]); }
#define P4_DPP(x, ctrl) __builtin_bit_cast(float, __builtin_amdgcn_update_dpp(0, __builtin_bit_cast(int, x), ctrl, 0xF, 0xF, false))
                {   const bool u3 = (lane & 8) != 0, u2 = (lane & 4) != 0, u1 = (lane & 2) != 0, u0 = (lane & 1) != 0;
#pragma unroll
                    for (int i = 0; i < 8; ++i) { const float lo_ = v[i], hi_ = v[i + 8]; const float send = u3 ? lo_ : hi_, keep = u3 ? hi_ : lo_; v[i] = keep + P4_DPP(send, 0x140); }
#pragma unroll
                    for (int i = 0; i < 4; ++i) { const float lo_ = v[i], hi_ = v[i + 4]; const float send = u2 ? lo_ : hi_, keep = u2 ? hi_ : lo_; v[i] = keep + P4_DPP(send, 0x141); }
#pragma unroll
                    for (int i = 0; i < 2; ++i) { const float lo_ = v[i], hi_ = v[i + 2]; const float send = u1 ? lo_ : hi_, keep = u1 ? hi_ : lo_; v[i] = keep + P4_DPP(send, 0x1B); }
                    {   const float lo_ = v[0], hi_ = v[1]; const float send = u0 ? lo_ : hi_, keep = u0 ? hi_ : lo_; v[0] = keep + P4_DPP(send, 0xB1); } }
                {   auto r = __builtin_amdgcn_permlane32_swap(__builtin_bit_cast(unsigned, v[0]), __builtin_bit_cast(unsigned, v[0]), false, false);
                    v[0] = __builtin_bit_cast(float, (unsigned)r[0]) + __builtin_bit_cast(float, (unsigned)r[1]); }
                if (lane < 32) ((LAS float*)P)[wave * 32 + lane] = v[0];
                if (s + 1 < NBLK) {
#pragma unroll
                    for (int q = 0; q < 4; ++q) *(LAS v4u*)(lds + ((s + 3) & 3) * 32768 + (pj + 4 * q) * 2048 + pch * 16) = pf[q];
                }
                v4u cxv[6], bbv[4];
#pragma unroll
                for (int r = 0; r < 6; ++r) { const int rr = 4 * tq - 2 + r;
                    cxv[r] = (v4u){0u, 0u, 0u, 0u}; if (!(s == 0 && seq_start && rr < 0)) cxv[r] = *(const GAS v4u*)(Z1 + (size_t)(t0 + rr) * D + co); }
#pragma unroll
                for (int r = 0; r < 4; ++r) bbv[r] = *(const GAS v4u*)(Z2 + (size_t)(t0 + 4 * tq + r) * D + co);
                __syncthreads();
                if (tid < 16) { float sm = 0.f, q = 0.f;
#pragma unroll
                    for (int w = 0; w < 8; ++w) { const f32x2 p = P[w * 16 + tid]; sm += p.x; q += p.y; }
                    const float mean = sm * (1.0f / D), var = fmaxf(q * (1.0f / D) - mean * mean, 0.f); Sx[tid] = (f32x2){mean, rsqrtf(var + EPS)}; }
                __syncthreads();
                float vm[16];
#pragma unroll
                for (int tt = 0; tt < 16; ++tt) {
                    const f32x2 st = Sx[tt]; const f32x2 y = (a[tt] - st.x) * st.y * lng + lnb;
                    a[tt] = (f32x2){y.x * sigmoidf_(y.x), y.y * sigmoidf_(y.y)};
                    vm[tt] = fmaxf(fabsf(a[tt].x), fabsf(a[tt].y));
                }
                {   const bool u3 = (lane & 8) != 0, u2 = (lane & 4) != 0, u1 = (lane & 2) != 0, u0 = (lane & 1) != 0;
#pragma unroll
                    for (int i = 0; i < 8; ++i) { const float lo_ = vm[i], hi_ = vm[i + 8]; const float send = u3 ? lo_ : hi_, keep = u3 ? hi_ : lo_; vm[i] = fmaxf(keep, P4_DPP(send, 0x140)); }
#pragma unroll
                    for (int i = 0; i < 4; ++i) { const float lo_ = vm[i], hi_ = vm[i + 4]; const float send = u2 ? lo_ : hi_, keep = u2 ? hi_ : lo_; vm[i] = fmaxf(keep, P4_DPP(send, 0x141)); }
#pragma unroll
                    for (int i = 0; i < 2; ++i) { const float lo_ = vm[i], hi_ = vm[i + 2]; const float send = u1 ? lo_ : hi_, keep = u1 ? hi_ : lo_; vm[i] = fmaxf(keep, P4_DPP(send, 0x1B)); }
                    {   const float lo_ = vm[0], hi_ = vm[1]; const float send = u0 ? lo_ : hi_, keep = u0 ? hi_ : lo_; vm[0] = fmaxf(keep, P4_DPP(send, 0xB1)); } }
                vm[0] = fq_max(vm[0]);
                if (lane < 16) Pm[wave * 16 + lane] = vm[0];
#undef P4_DPP
                __syncthreads();
                if (tid < 16) { float mx = Pm[tid];
#pragma unroll
                    for (int w = 1; w < 8; ++w) mx = fmaxf(mx, Pm[w * 16 + tid]);
                    mx = fmaxf(mx, 1e-20f); Sm[tid] = 127.0f / mx; rsA[t0 + tid] = mx * (1.0f / 127.0f); }
                __syncthreads();
#pragma unroll
                for (int tt = 0; tt < 16; ++tt) {
                    const float inv = Sm[tt];
                    unsigned q = 0u;
                    q = __builtin_amdgcn_cvt_pk_u8_f32(__builtin_rintf(a[tt].x * inv) + 128.0f, 0, q);
                    q = __builtin_amdgcn_cvt_pk_u8_f32(__builtin_rintf(a[tt].y * inv) + 128.0f, 1, q);
                    *(GAS unsigned short*)((GAS unsigned char*)RA + (size_t)(t0 + tt) * (2 * D) + c0) = (unsigned short)(q ^ 0x8080u);
                }
                if (!args.skip_b) {
                    f32x4 x0[6], x1[6];
#pragma unroll
                    for (int r = 0; r < 6; ++r) unpack8(cxv[r], x0[r], x1[r]);
#pragma unroll
                    for (int j = 0; j < 4; ++j) { f32x4 b0, b1; unpack8(bbv[j], b0, b1);
                        const f32x4 v0 = (wB[0][0] * x0[j] + wB[1][0] * x0[j + 1] + wB[2][0] * x0[j + 2]) * b0, v1 = (wB[0][1] * x1[j] + wB[1][1] * x1[j + 1] + wB[2][1] * x1[j + 2]) * b1;
                        *(GAS v4u*)(Z2 + (size_t)(t0 + 4 * tq + j) * D + co) = pack8(v0, v1); }
                }
            }
            __syncthreads();
        }
    }
    SEAM_L(4);
    if (IN(5)) {
        pg8::Gemm g{RA, WA, Z + 2 * ZK, WB, M, D, D, 0, ZX * 2}; pg8::DualOrderT<M / 256, D / 256> S; S.s.init(G, bx);
        EpiMix E{Z + 3 * ZS, Z + 4 * ZS, Z, rsA, sBa};
        pg8::gemm_phase<EpiMix, pg8::DualOrderT<M / 256, D / 256>, PG8_ALIGN, PG8_SP2>(lds, g, S, E); PSAVE(5);
    }
    SEAM_L(5);
    if (IN(6)) {
        pg8::Gemm g{Z, WO, nullptr, nullptr, M, D, D, ZX * 2, 0}; pg8::StaticOrderT<M / 256, D / 256> S; S.init(G, bx);
#if MK_Q2
        typedef EpiResidQT<0, HBX * 2> EpiResidQ6;
        EpiResidQ6 E{HB1, RA, QA, rowinfo3, (unsigned long long*)(ws + WS_XBUF2), (unsigned*)(ctl + CW_PANEL2), lds, 1.0f};
        pg8::gemm_phase<EpiResidQ6, pg8::StaticOrderT<M / 256, D / 256>, PG8_ALIGN, PG8_SP2>(lds, g, S, E); PSAVE(6);
#else
        EpiResid<true> E{nullptr, HB1, RA, ssp3, 1.0f};
        pg8::gemm_phase<EpiResid<true>, pg8::StaticOrderT<M / 256, D / 256>, PG8_ALIGN, PG8_SP2>(lds, g, S, E); PSAVE(6);
#endif
    }
    SEAM_L(6);
    if (IN(7)) {
#if MK_Q2
        pg8::Gemm g{(const bf16*)QA, (const bf16*)W2q, nullptr, nullptr, M, 2 * FF, D / 2}; pg8::StaticOrderT<M / 256, 2 * FF / 256> S; S.init(G, bx);
        EpiSwigluQ E{HID, sB2, RowScaleStash{(LAS float*)(lds + RING_BYTES + 1024), rowinfo3, -1, -1, -1, -1}};
        pg8::gemm_phase<EpiSwigluQ, pg8::StaticOrderT<M / 256, 2 * FF / 256>, true, true>(lds, g, S, E); PSAVE(7);
#else
        pg8::Gemm g{RA, W2, nullptr, nullptr, M, 2 * FF, D}; pg8::StaticOrderT<M / 256, 2 * FF / 256> S; S.init(G, bx);
        EpiSwiglu E{HID, RstdStash{(LAS float*)(lds + RING_BYTES + 1024), ssp3, -1, -1, -1, -1}};
        pg8::gemm_phase<EpiSwiglu, pg8::StaticOrderT<M / 256, 2 * FF / 256>, true, true>(lds, g, S, E); PSAVE(7);
#endif
    }
    SEAM_L(7);
    if (IN(8)) {
        pg8::Gemm g{HID, WD2, nullptr, nullptr, M, D, FF, HX * 2, 0}; pg8::StaticOrderT<M / 256, D / 256> S; S.init(G, bx);
        float padd = 0.f;
#ifdef MK_PROBE
        {   const int ka = MK_PROBE_A;
            if (ka != 21) padd = 0.02f * ((ka < 16) ? (float)(long long)(stamps[ka + 1] - stamps[ka]) * 0.01f : (float)(long long)(stamps[8] - stamps[0]) * 0.001f); }
#endif
        EpiFinal E{RA, out, args.in[19], (float*)(ws + WS_XBUF), (unsigned*)(ctl + CW_PANEL), lds, 0.5f, padd};
        pg8::gemm_phase<EpiFinal, pg8::StaticOrderT<M / 256, D / 256>, PG8_ALIGN, PG8_SP2>(lds, g, S, E); PSAVE(8);
#ifdef MK_PROBE
        if (MK_PROBE_A == 21 && bx == 0 && tid == 0) { VM_WAIT(); out[0] += 0.02f * 0.001f * (float)(long long)(__builtin_amdgcn_s_memrealtime() - stamps[0]); }
#endif
    }
#undef IN
#undef SEAM
#undef SEAM_L
}

extern "C" void kernel_launch(void* const* d_in, const int* in_sizes, int n_in, void* d_out, int out_size, void* d_ws, size_t ws_size, hipStream_t stream) {
    static int grid = 0;
    if (grid == 0) {
        if (n_in != 20 || in_sizes[0] != M * D || out_size != M * D || ws_size < WS_END) {
            fprintf(stderr, "kernel_launch: built for 20 inputs, x/out of %d floats, >= %zu bytes of workspace; got n_in %d, in0 %d, out %d, ws %zu; nothing launched\n", M * D, (size_t)WS_END, n_in, n_in > 0 ? in_sizes[0] : -1, out_size, ws_size);
            grid = -1; return; }
        int dev = 0, cus = 0, per_cu = 0;
        if (hipGetDevice(&dev) != hipSuccess || hipDeviceGetAttribute(&cus, hipDeviceAttributeMultiprocessorCount, dev) != hipSuccess) { fprintf(stderr, "kernel_launch: device query failed\n"); grid = -1; return; }
        if (hipFuncSetAttribute((const void*)mk_fwd, hipFuncAttributeMaxDynamicSharedMemorySize, LDS_BYTES) != hipSuccess) { fprintf(stderr, "kernel_launch: hipFuncSetAttribute failed\n"); grid = -1; return; }
        if (hipOccupancyMaxActiveBlocksPerMultiprocessor(&per_cu, (const void*)mk_fwd, NWAVES * 64, LDS_BYTES) != hipSuccess || per_cu < 1) { fprintf(stderr, "kernel_launch: occupancy query says %d blocks per CU\n", per_cu); per_cu = 1; }
        (void)hipGetLastError();
        grid = cus > 256 ? 256 : cus;
        grid -= grid % 32;
        if (grid != 256) fprintf(stderr, "kernel_launch: note: %d CUs -> grid %d (tuned for 256)\n", cus, grid);
        if (grid < 32) { grid = -1; return; }
    }
    if (grid < 0) return;
    if (hipMemsetAsync((char*)d_ws + WS_CTL, 0, CTL_ZERO_BYTES, stream) != hipSuccess) { fprintf(stderr, "kernel_launch: memset failed\n"); return; }
    Args a{};
    for (int i = 0; i < 20; ++i) a.in[i] = (const float*)d_in[i];
    a.out = (float*)d_out; a.ws = (unsigned char*)d_ws;
    if (MK_REP_PHASE >= 0) {
        a.ph_lo = 0; a.ph_hi = MK_REP_PHASE + 1; a.use_bar = 1; a.skip_b = (MK_REP_PHASE == 4);
        hipLaunchKernelGGL(mk_fwd, dim3(grid), dim3(NWAVES * 64), LDS_BYTES, stream, a);
        (void)hipMemsetAsync((char*)d_ws + WS_CTL, 0, CTL_ZERO_BYTES, stream);
        a.ph_lo = MK_REP_PHASE; a.ph_hi = N_PHASES; a.skip_b = 0;
        hipLaunchKernelGGL(mk_fwd, dim3(grid), dim3(NWAVES * 64), LDS_BYTES, stream, a);
    } else if (MK_N_LAUNCHES == 1) {
        a.ph_lo = 0; a.ph_hi = N_PHASES; a.use_bar = 1;
        hipLaunchKernelGGL(mk_fwd, dim3(grid), dim3(NWAVES * 64), LDS_BYTES, stream, a);
    } else {
        for (int p = 0; p < N_PHASES; ++p) { a.ph_lo = p; a.ph_hi = p + 1; a.use_bar = 0;
            hipLaunchKernelGGL(mk_fwd, dim3(grid), dim3(NWAVES * 64), LDS_BYTES, stream, a); }
    }
    const hipError_t le = hipPeekAtLastError();
    if (le != hipSuccess) fprintf(stderr, "kernel_launch: launch failed: %s\n", hipGetErrorName(le));
}
```
